# Optimizing an MI355X kernel written in HIP

```python
import jax, jax.numpy as jnp
from jax import lax
import numpy as np

D_MODEL = 1024
BATCH = 8
SEQ = 2048
DEPTH = 1

GRID_W = 64
CTX_LEN = 256
CONV_DIM = 512
CONV_K = 31
GLA_HEADS = 4
GLA_DK = 64
GLA_DV = 128
DECAY_RANK = 16
GATE_NORM = 16.0
CHUNK = 64
D_FF = 4 * D_MODEL
N_MOD = 6
EPS = 1e-6

COL_GLU = 0
COL_Q = COL_GLU + 2 * CONV_DIM
COL_K = COL_Q + GLA_HEADS * GLA_DK
COL_V = COL_K + GLA_HEADS * GLA_DK
COL_R = COL_V + GLA_HEADS * GLA_DV
COL_DEC = COL_R + GLA_HEADS * GLA_DV
COL_GATE = COL_DEC + 2 * DECAY_RANK
COL_END = COL_GATE + 2 * D_MODEL

kernel_name = "hybrid_conformer_gla_dit_block"


def rmsnorm(x, g):
    x32 = x.astype(jnp.float32)
    y = x32 * lax.rsqrt(jnp.mean(x32 * x32, axis=-1, keepdims=True) + EPS)
    return (y * g).astype(x.dtype)


def layernorm(x, g, b):
    x32 = x.astype(jnp.float32)
    mu = jnp.mean(x32, axis=-1, keepdims=True)
    var = jnp.mean(jnp.square(x32 - mu), axis=-1, keepdims=True)
    y = (x32 - mu) * lax.rsqrt(var + EPS)
    return (y * g + b).astype(x.dtype)


def adaln(cvec, w_mod, b_mod, n):
    m = jax.nn.silu(cvec) @ w_mod[:, :n * D_MODEL] + b_mod[:n * D_MODEL]
    return jnp.split(m[:, None, :], n, axis=-1)


def modulate(xn, shift, scale):
    return xn * (1.0 + scale) + shift


def heads(a, d):
    B_, T, _ = a.shape
    return a.reshape(B_, T, -1, d).transpose(0, 2, 1, 3)


def flip_t(a):
    return jnp.flip(a, axis=2)


def dwconv1d(x, w, b):
    y = lax.conv_general_dilated(
        x, w[:, None, :], window_strides=(1,),
        padding=[(CONV_K // 2, CONV_K // 2)],
        dimension_numbers=("NWC", "WIO", "NWC"),
        feature_group_count=x.shape[-1])
    return y + b


def conv_grid(a, w, b, rows):
    B_, T, C = a.shape
    half = C // 2
    g = a.reshape(B_, rows, GRID_W, C)
    ah = g[..., :half].reshape(B_ * rows, GRID_W, half)
    yh = dwconv1d(ah, w[:, :half], b[:half]).reshape(B_, rows, GRID_W, half)
    av = g[..., half:].transpose(0, 2, 1, 3).reshape(B_ * GRID_W, rows, half)
    yv = dwconv1d(av, w[:, half:], b[half:]).reshape(B_, GRID_W, rows, half).transpose(0, 2, 1, 3)
    return jnp.concatenate([yh, yv], axis=-1).reshape(B_, T, C)


def decay_logs(z, w_decay, b_decay):
    B_, T, _ = z.shape
    z = z.reshape(B_, T, 2, DECAY_RANK)
    logits = jnp.einsum("btdr,drk->btdk", z, w_decay) + b_decay
    la = jax.nn.log_sigmoid(logits.astype(jnp.float32)) / GATE_NORM
    return heads(la[:, :, 0], GLA_DK), heads(la[:, :, 1], GLA_DK)


def gla_scan(q, k, v, la, S0):
    B_, H, T, _ = q.shape
    n = T // CHUNK

    def chunks(a):
        return a.reshape(B_, H, n, CHUNK, a.shape[-1]).transpose(2, 0, 1, 3, 4)

    lower = jnp.tril(jnp.ones((CHUNK, CHUNK), dtype=bool))[:, :, None]

    def step(S, inp):
        qc, kc, vc, lac = inp
        G = jnp.cumsum(lac, axis=2)
        diff = G[:, :, :, None, :] - G[:, :, None, :, :]
        dec = jnp.exp(jnp.where(lower, diff, -jnp.inf))
        A = jnp.einsum("bhid,bhjd,bhijd->bhij", qc, kc, dec)
        o = (jnp.einsum("bhij,bhjv->bhiv", A, vc)
             + jnp.einsum("bhid,bhdv->bhiv", qc * jnp.exp(G), S))
        G_last = G[:, :, -1:, :]
        S_new = (jnp.exp(G_last[:, :, 0, :, None]) * S
                 + jnp.einsum("bhjd,bhjv->bhdv", kc * jnp.exp(G_last - G), vc))
        return S_new, o

    S_fin, o = lax.scan(step, S0, (chunks(q), chunks(k), chunks(v), chunks(la)))
    o = o.transpose(1, 2, 0, 3, 4).reshape(B_, H, T, v.shape[-1])
    return o, S_fin


def gla_final_state(k, v, la):
    G = jnp.cumsum(la, axis=2)
    return jnp.einsum("bhtd,bhtv->bhdv", k * jnp.exp(G[:, :, -1:] - G), v)


def context_states(uc, w_in, w_decay, b_decay):
    kv = uc @ w_in[:, COL_K:COL_R]
    k_c = heads(kv[..., :GLA_HEADS * GLA_DK], GLA_DK)
    v_c = heads(kv[..., GLA_HEADS * GLA_DK:], GLA_DV)
    la_f, la_b = decay_logs(uc @ w_in[:, COL_DEC:COL_GATE], w_decay, b_decay)
    S_f = gla_final_state(k_c, v_c, la_f)
    S_b = gla_final_state(flip_t(k_c), flip_t(v_c), flip_t(la_b))
    return S_f, S_b


def mixer(u, rows, S_f0, S_b0, w_in, conv_w, conv_b, conv_ln_g, conv_ln_b,
          w_conv_out, w_decay, b_decay, gla_norm_g, w_gla_out, w_out):
    B_, T, _ = u.shape
    proj = u @ w_in
    glu_in = proj[..., COL_GLU:COL_Q]
    a = glu_in[..., :CONV_DIM] * jax.nn.sigmoid(glu_in[..., CONV_DIM:])
    a = conv_grid(a, conv_w, conv_b, rows) if rows is not None else dwconv1d(a, conv_w, conv_b)
    y_conv = jax.nn.silu(layernorm(a, conv_ln_g, conv_ln_b)) @ w_conv_out
    q = heads(proj[..., COL_Q:COL_K], GLA_DK) * (GLA_DK ** -0.5)
    k = heads(proj[..., COL_K:COL_V], GLA_DK)
    v = heads(proj[..., COL_V:COL_R], GLA_DV)
    r = proj[..., COL_R:COL_DEC]
    la_f, la_b = decay_logs(proj[..., COL_DEC:COL_GATE], w_decay, b_decay)
    o_f, _ = gla_scan(q, k, v, la_f, S_f0)
    o_b, _ = gla_scan(flip_t(q), flip_t(k), flip_t(v), flip_t(la_b), S_b0)
    o = rmsnorm(o_f + flip_t(o_b), gla_norm_g)
    o = o.transpose(0, 2, 1, 3).reshape(B_, T, GLA_HEADS * GLA_DV).astype(u.dtype)
    y_gla = (o * jax.nn.silu(r)) @ w_gla_out
    gates = jax.nn.sigmoid(proj[..., COL_GATE:COL_END])
    merged = gates[..., :D_MODEL] * y_conv + gates[..., D_MODEL:] * y_gla
    return merged @ w_out


def sq_relu_mlp(u, w_ff1, w_ff2):
    return jnp.square(jax.nn.relu(u @ w_ff1)) @ w_ff2


def setup_inputs(seed: int = 0) -> dict:
    key = jax.random.key(seed)
    ks = jax.random.split(key, 24)
    D = D_MODEL
    f32 = jnp.float32

    def nrm(k, shape, scale):
        return jax.random.normal(k, shape, f32) * scale

    return {
        "x": nrm(ks[0], (BATCH, SEQ, D), 1.0),
        "c": nrm(ks[1], (BATCH, D), 1.0),
        "ctx": nrm(ks[2], (BATCH, CTX_LEN, D), 1.0),
        "c_ctx": nrm(ks[3], (D,), 1.0),
        "w_mod": nrm(ks[4], (DEPTH, D, N_MOD * D), 0.5 * D ** -0.5),
        "b_mod": nrm(ks[5], (DEPTH, N_MOD * D), 0.01),
        "g_pre1": 1.0 + nrm(ks[6], (DEPTH, D), 0.05),
        "g_post1": 1.0 + nrm(ks[7], (DEPTH, D), 0.05),
        "g_pre2": 1.0 + nrm(ks[8], (DEPTH, D), 0.05),
        "g_post2": 1.0 + nrm(ks[9], (DEPTH, D), 0.05),
        "w_in": nrm(ks[10], (DEPTH, D, COL_END), D ** -0.5),
        "conv_w": nrm(ks[11], (DEPTH, CONV_K, CONV_DIM), CONV_K ** -0.5),
        "conv_b": nrm(ks[12], (DEPTH, CONV_DIM), 0.01),
        "conv_ln_g": 1.0 + nrm(ks[13], (DEPTH, CONV_DIM), 0.05),
        "conv_ln_b": nrm(ks[14], (DEPTH, CONV_DIM), 0.01),
        "w_conv_out": nrm(ks[15], (DEPTH, CONV_DIM, D), CONV_DIM ** -0.5),
        "w_decay": nrm(ks[16], (DEPTH, 2, DECAY_RANK, GLA_HEADS * GLA_DK), DECAY_RANK ** -0.5),
        "b_decay": nrm(ks[17], (DEPTH, 2, GLA_HEADS * GLA_DK), 0.5),
        "gla_norm_g": 1.0 + nrm(ks[18], (DEPTH, GLA_DV), 0.05),
        "w_gla_out": nrm(ks[19], (DEPTH, GLA_HEADS * GLA_DV, D), (GLA_HEADS * GLA_DV) ** -0.5),
        "w_out": nrm(ks[20], (DEPTH, D, D), D ** -0.5),
        "w_ff1": nrm(ks[21], (DEPTH, D, D_FF), D ** -0.5),
        "w_ff2": nrm(ks[22], (DEPTH, D_FF, D), D_FF ** -0.5),
    }


def reference(x, c, ctx, c_ctx, w_mod, b_mod, g_pre1, g_post1, g_pre2, g_post2,
              w_in, conv_w, conv_b, conv_ln_g, conv_ln_b, w_conv_out, w_decay,
              b_decay, gla_norm_g, w_gla_out, w_out, w_ff1, w_ff2):
    rows = x.shape[1] // GRID_W
    h = x
    hc = ctx
    cc = c_ctx[None, :]
    for l in range(DEPTH):
        mp = (w_in[l], conv_w[l], conv_b[l], conv_ln_g[l], conv_ln_b[l], w_conv_out[l],
              w_decay[l], b_decay[l], gla_norm_g[l], w_gla_out[l], w_out[l])
        sh1, sc1, gt1, sh2, sc2, gt2 = adaln(c, w_mod[l], b_mod[l], N_MOD)
        csh1, csc1 = adaln(cc, w_mod[l], b_mod[l], 2)
        uc = modulate(rmsnorm(hc, g_pre1[l]), csh1, csc1)
        S_f, S_b = context_states(uc, w_in[l], w_decay[l], b_decay[l])
        u = modulate(rmsnorm(h, g_pre1[l]), sh1, sc1)
        y = mixer(u, rows, S_f, S_b, *mp)
        h_mid = h + gt1 * rmsnorm(y, g_post1[l])
        u2 = modulate(rmsnorm(h_mid, g_pre2[l]), sh2, sc2)
        h_new = h_mid + gt2 * rmsnorm(sq_relu_mlp(u2, w_ff1[l], w_ff2[l]), g_post2[l])
        if l < DEPTH - 1:
            _, _, cgt1, csh2, csc2, cgt2 = adaln(cc, w_mod[l], b_mod[l], N_MOD)
            zeros = jnp.zeros((hc.shape[0], GLA_HEADS, GLA_DK, GLA_DV), jnp.float32)
            yc = mixer(uc, None, zeros, zeros, *mp)
            hc_mid = hc + cgt1 * rmsnorm(yc, g_post1[l])
            uc2 = modulate(rmsnorm(hc_mid, g_pre2[l]), csh2, csc2)
            hc = hc_mid + cgt2 * rmsnorm(sq_relu_mlp(uc2, w_ff1[l], w_ff2[l]), g_post2[l])
        h = h_new
    return h
```

```cpp
#include <hip/hip_runtime.h>
#include <hip/hip_cooperative_groups.h>
#include <cstdio>
#include <cstdint>
namespace cg = cooperative_groups;

#define LAS __attribute__((address_space(3)))
typedef unsigned short bf16_t;
typedef short bf16x8 __attribute__((ext_vector_type(8)));
typedef float f32x4 __attribute__((ext_vector_type(4)));
typedef float f32x2 __attribute__((ext_vector_type(2)));
typedef unsigned u32x4 __attribute__((ext_vector_type(4)));
typedef unsigned u32x2 __attribute__((ext_vector_type(2)));

#ifndef MK_MULTI_LAUNCH
#define MK_MULTI_LAUNCH 0
#endif

constexpr int D = 1024, NB = 8, SEQ = 2048, MTOK = NB * SEQ, CTXL = 256, MCTX = NB * CTXL;
constexpr int CONVD = 512, CK = 31, NH = 4, DK = 64, DV = 128, DFF = 4096, NMOD = 6;
constexpr int COLEND = 4640;
constexpr int NPROJ = 19 * 256;
constexpr int NCH = 36;
constexpr float EPS = 1e-6f;
constexpr int NTHREADS = 512, NWAVES = 8;
constexpr int LDS_BYTES = 160 * 1024;

constexpr size_t WS_WIN = 0;
constexpr size_t WS_WFF1 = WS_WIN + (size_t)NPROJ * D * 2;
constexpr size_t WS_WFF2 = WS_WFF1 + (size_t)DFF * D * 2;
constexpr size_t WS_WOUT = WS_WFF2 + (size_t)D * DFF * 2;
constexpr size_t WS_WCONV = WS_WOUT + (size_t)D * D * 2;
constexpr size_t WS_WGLA = WS_WCONV + (size_t)D * CONVD * 2;
constexpr size_t WS_MOD = WS_WGLA + (size_t)D * 512 * 2;
constexpr size_t WS_CMOD = WS_MOD + (size_t)NB * NMOD * D * 4;
constexpr size_t WS_UC = WS_CMOD + (size_t)2 * D * 4;
constexpr size_t WS_KC = WS_UC + (size_t)MCTX * D * 2;
constexpr size_t WS_VC = WS_KC + (size_t)MCTX * 256 * 2;
constexpr size_t WS_DECC = WS_VC + (size_t)MCTX * 512 * 2;
constexpr size_t WS_DVEC = WS_DECC + (size_t)MCTX * 32 * 4;
constexpr size_t WS_U = WS_DVEC + (size_t)2 * NB * NH * NCH * 64 * 4;
constexpr size_t WS_G = WS_U + (size_t)MTOK * D * 2;
constexpr size_t WS_P = WS_G + (size_t)2 * NB * NH * NCH * 8192 * 2;
constexpr size_t WS_AGLU = WS_P;
constexpr size_t WS_Q = WS_AGLU + (size_t)MTOK * 512 * 2;
constexpr size_t WS_K = WS_Q + (size_t)MTOK * 256 * 2;
constexpr size_t WS_V = WS_K + (size_t)MTOK * 256 * 2;
constexpr size_t WS_R = WS_V + (size_t)MTOK * 512 * 2;
constexpr size_t WS_GATE = WS_R + (size_t)MTOK * 512 * 2;
constexpr size_t WS_DEC = WS_GATE + (size_t)MTOK * 2048 * 2;
constexpr size_t WS_END = WS_DEC + (size_t)MTOK * 32 * 4;
constexpr size_t WS_MERGED = WS_Q;
constexpr size_t WS_FFACT = WS_P;
constexpr size_t WS_FF2OUT = WS_U;
constexpr size_t WS_Y = WS_G;
constexpr size_t WS_BAR = WS_END;
constexpr int XCD_BAR_WORDS = 3456;
constexpr size_t WS_XCNT = WS_BAR + 16384;
constexpr size_t WS_XBUF = WS_XCNT + 3 * 16384;
constexpr size_t CTL_ZERO_BYTES = 16384 + 3 * 16384;
static_assert(WS_XBUF + 3 * (size_t)MTOK * 16 <= (size_t)256 * 1024 * 1024, "workspace (exchange)");
static_assert(WS_BAR + XCD_BAR_WORDS * 4 <= (size_t)256 * 1024 * 1024, "workspace");
static_assert((size_t)MTOK * DFF * 2 <= WS_END - WS_P, "ffact overlay");
static_assert((size_t)MTOK * D * 4 <= WS_P - WS_U, "ff2out overlay");
static_assert(WS_V + (size_t)MTOK * 512 * 2 - WS_Q == (size_t)MTOK * D * 2, "merged overlay");

struct Params {
    const float *x, *c, *ctx, *c_ctx, *w_mod, *b_mod, *g_pre1, *g_post1, *g_pre2, *g_post2, *w_in, *conv_w, *conv_b, *conv_ln_g, *conv_ln_b,
        *w_conv_out, *w_decay, *b_decay, *gla_norm_g, *w_gla_out, *w_out, *w_ff1, *w_ff2;
    float* out; unsigned char* ws;
    int ph_lo, ph_hi;
};

typedef __bf16 bf16x2_t __attribute__((ext_vector_type(2)));
typedef _Float16 h2_t __attribute__((ext_vector_type(2)));
__device__ __forceinline__ h2_t as_h2(unsigned u) { return __builtin_bit_cast(h2_t, u); }
__device__ __forceinline__ unsigned cvt_pk_f16(float lo, float hi) { h2_t v; v.x = (_Float16)lo; v.y = (_Float16)hi; return __builtin_bit_cast(unsigned, v); }
__device__ __forceinline__ unsigned cvt_pk_bf16(float lo, float hi) { bf16x2_t v; v.x = (__bf16)lo; v.y = (__bf16)hi; return __builtin_bit_cast(unsigned, v); }
__device__ __forceinline__ bf16_t f2bf(float x) { return __builtin_bit_cast(bf16_t, (__bf16)x); }
__device__ __forceinline__ float bf2f(unsigned h) { return __uint_as_float(h << 16); }
__device__ __forceinline__ float bflo(unsigned w) { return __uint_as_float(w << 16); }
__device__ __forceinline__ float bfhi(unsigned w) { return __uint_as_float(w & 0xffff0000u); }
__device__ __forceinline__ void unpack8(const u32x4 a, float (&f)[8]) {
    f[0] = bflo(a.x); f[1] = bfhi(a.x); f[2] = bflo(a.y); f[3] = bfhi(a.y); f[4] = bflo(a.z); f[5] = bfhi(a.z); f[6] = bflo(a.w); f[7] = bfhi(a.w);
}
__device__ __forceinline__ float wave_sum(float v) {
#pragma unroll
    for (int o = 1; o < 64; o <<= 1) v += __shfl_xor(v, o);
    return v;
}
__device__ __forceinline__ float sigmoidf_(float x) { return __builtin_amdgcn_rcpf(1.0f + __expf(-x)); }
__device__ __forceinline__ float siluf_(float x) { return x * sigmoidf_(x); }

#define XB_SPIN_CAP (1u << 18)
__device__ __forceinline__ unsigned xb_ld(unsigned* p)              { return __hip_atomic_load(p, __ATOMIC_RELAXED, __HIP_MEMORY_SCOPE_AGENT); }
constexpr int BM = 256, BK = 64, HALF = 128, HTB = HALF * BK * 2, NXCD = 8, WGM = 4;
__device__ __forceinline__ int lds_byte(int r, int c) { const int st = (r >> 4) * 2 + (c >> 5), rr = r & 15, cc = c & 31, ob = rr * 64 + cc * 2; return st * 1024 + (ob ^ (((ob >> 9) & 1) << 5)); }
__device__ __forceinline__ void stage_rc(int b, int& R, int& C) { const int st = b / 1024, sb = b % 1024, swz = sb ^ (((sb >> 9) & 1) << 5); R = (st >> 1) * 16 + swz / 64; C = (st & 1) * 32 + (swz % 64) / 2; }
__device__ __forceinline__ int perm32(int rho) { const int n = rho >> 4, i = rho & 15; return 8 * (i >> 2) + 4 * n + (i & 3); }

struct Unit { const char* A; const char* B; int pm, pn, kind; };

__device__ __forceinline__ void tile_remap(int L, int nM, int nN, int& pm, int& pn) {
    const int nwg = nM * nN; int wgid = L;
    { const int q = nwg / NXCD, r = nwg % NXCD, xcd = wgid % NXCD, off = wgid / NXCD; wgid = (xcd < r ? xcd * (q + 1) : r * (q + 1) + (xcd - r) * q) + off; }
    const int nig = WGM * nN, gid = wgid / nig, fm = gid * WGM, gsz = (nM - fm) < WGM ? (nM - fm) : WGM;
    pm = fm + ((wgid % nig) % gsz); pn = (wgid % nig) / gsz;
    pn = (pn + ((L % NXCD) * nN) / NXCD) % nN;
}

template <int K, class Sched, class Epi>
__device__ __forceinline__ void gemm_phase(LAS unsigned char* lds, const Sched& S, const Epi& E) {
    const int tid = threadIdx.x, wid = __builtin_amdgcn_readfirstlane(tid >> 6), lane = tid & 63, wr = wid >> 2, wc = wid & 3, fr = lane & 15, fq = lane >> 4;
    constexpr int nt = K / BK;
    unsigned voffA[2], voffB[2];
#pragma unroll
    for (int i = 0; i < 2; ++i) { int R, C; stage_rc(tid * 16 + i * 8192, R, C); const int Rb = (R & ~31) + perm32(R & 31);
        voffA[i] = (unsigned)(R * K + C) * 2u; voffB[i] = (unsigned)(Rb * K + C) * 2u; }
    constexpr size_t kstep = (size_t)(BK * 2);
    constexpr size_t hstep = (size_t)HALF * K * 2;
    const unsigned ldsw = (unsigned)wid * 1024u;
    const int aoff = lds_byte(wr * 64 + fr, fq * 8), boff = lds_byte(wc * 32 + fr, fq * 8);
#define PG8_SA(b, h) (((b) * 2 + (h)) * HTB)
#define PG8_SB(b, h) ((4 + (b) * 2 + (h)) * HTB)
#define PG8_STAGE(bufoff, gbase, voff) do { _Pragma("unroll") for (int _i = 0; _i < 2; ++_i) \
        __builtin_amdgcn_global_load_lds((const unsigned*)((const char*)(gbase) + (voff)[_i]), (LAS unsigned*)(lds + (bufoff) + ldsw + _i * 8192), 16, 0, 0); } while (0)
#define PG8_LDA(dst, b, h) do { _Pragma("unroll") for (int m = 0; m < 4; ++m) _Pragma("unroll") for (int k = 0; k < 2; ++k) dst[m][k] = *(const LAS bf16x8*)(lds + PG8_SA(b, h) + aoff + m * 2048 + k * 1024); } while (0)
#define PG8_LDB(dst, b, h) do { _Pragma("unroll") for (int n = 0; n < 2; ++n) _Pragma("unroll") for (int k = 0; k < 2; ++k) dst[n][k] = *(const LAS bf16x8*)(lds + PG8_SB(b, h) + boff + n * 2048 + k * 1024); } while (0)
#define PG8_MMA(ai, bj, At, Bt) do { __builtin_amdgcn_s_setprio(1); _Pragma("unroll") for (int m = 0; m < 4; ++m) _Pragma("unroll") for (int n = 0; n < 2; ++n) _Pragma("unroll") for (int k = 0; k < 2; ++k) \
        acc[ai][bj][m][n] = __builtin_amdgcn_mfma_f32_16x16x32_bf16(Bt[n][k], At[m][k], acc[ai][bj][m][n], 0, 0, 0); __builtin_amdgcn_s_setprio(0); } while (0)
#define PG8_WAIT_V(n) asm volatile("s_waitcnt vmcnt(" #n ")" ::: "memory")
#define PG8_WAIT_L(n) asm volatile("s_waitcnt lgkmcnt(" #n ")" ::: "memory")
#define PG8_BAR __builtin_amdgcn_s_barrier()
#define PG8_SCHED __builtin_amdgcn_sched_barrier(0)
    Unit cur, nxt; int ui = 0;
    if (!S.next(0, cur)) return;
    f32x4 acc[2][2][4][2];
#pragma unroll
    for (int a = 0; a < 2; ++a)
#pragma unroll
        for (int b = 0; b < 2; ++b)
#pragma unroll
            for (int m = 0; m < 4; ++m)
#pragma unroll
                for (int n = 0; n < 2; ++n) acc[a][b][m][n] = (f32x4){0.f, 0.f, 0.f, 0.f};
    bf16x8 At[4][2], B0[2][2], B1[2][2];
    const char* cA = cur.A; const char* cB = cur.B;
    const int krot = (nt >= 16) ? 2 * (int)(blockIdx.x % NXCD) : 0;
#define KOFF(t) ((size_t)(((t) + krot) & (nt - 1)) * kstep)
    PG8_STAGE(PG8_SB(0, 0), cB + KOFF(0), voffB); PG8_STAGE(PG8_SB(0, 1), cB + hstep + KOFF(0), voffB); PG8_STAGE(PG8_SA(0, 0), cA + KOFF(0), voffA); PG8_STAGE(PG8_SA(0, 1), cA + hstep + KOFF(0), voffA);
    if (wr == 1) PG8_BAR;
    PG8_WAIT_V(2); PG8_BAR;
    PG8_STAGE(PG8_SB(1, 0), cB + KOFF(1), voffB); PG8_STAGE(PG8_SA(1, 0), cA + KOFF(1), voffA); PG8_STAGE(PG8_SB(1, 1), cB + hstep + KOFF(1), voffB);
    PG8_WAIT_V(6); PG8_BAR;
    for (;;) {
        const bool has_next = S.next(ui + 1, nxt);
        const char* nA = has_next ? nxt.A : cA; const char* nB = has_next ? nxt.B : cB;
        for (int t = 0; t < nt; t += 2) {
            const bool last = (t == nt - 2);
            const char* a1 = cA + KOFF(t + 1);
            const char* a2 = last ? nA + KOFF(0) : cA + KOFF(t + 2); const char* b2 = last ? nB + KOFF(0) : cB + KOFF(t + 2);
            const char* a3 = last ? nA + KOFF(1) : cA + KOFF(t + 3); const char* b3 = last ? nB + KOFF(1) : cB + KOFF(t + 3);
            PG8_LDB(B0, 0, 0); PG8_LDB(B1, 0, 1); PG8_SCHED; PG8_LDA(At, 0, 0); PG8_STAGE(PG8_SA(1, 1), a1 + hstep, voffA);
            PG8_WAIT_V(8); PG8_WAIT_L(0); PG8_BAR; PG8_MMA(0, 0, At, B0); PG8_MMA(0, 1, At, B1); PG8_BAR; PG8_SCHED;
            PG8_LDA(At, 0, 1); PG8_STAGE(PG8_SB(0, 0), b2, voffB); PG8_STAGE(PG8_SB(0, 1), b2 + hstep, voffB); PG8_STAGE(PG8_SA(0, 0), a2, voffA);
            PG8_WAIT_V(8); PG8_WAIT_L(0); PG8_BAR; PG8_MMA(1, 0, At, B0); PG8_MMA(1, 1, At, B1); PG8_BAR; PG8_SCHED;
            PG8_LDB(B0, 1, 0); PG8_LDB(B1, 1, 1); PG8_SCHED; PG8_LDA(At, 1, 0); PG8_STAGE(PG8_SA(0, 1), a2 + hstep, voffA);
            PG8_WAIT_V(8); PG8_WAIT_L(0); PG8_BAR; PG8_MMA(0, 0, At, B0); PG8_MMA(0, 1, At, B1); PG8_BAR; PG8_SCHED;
            PG8_LDA(At, 1, 1); PG8_STAGE(PG8_SB(1, 0), b3, voffB); PG8_STAGE(PG8_SB(1, 1), b3 + hstep, voffB); PG8_STAGE(PG8_SA(1, 0), a3, voffA);
            PG8_WAIT_V(8); PG8_WAIT_L(0); PG8_BAR; PG8_MMA(1, 0, At, B0); PG8_MMA(1, 1, At, B1); PG8_BAR; PG8_SCHED;
        }
        if (wr == 0) PG8_BAR;
        bool keep = false;
        if constexpr (Epi::CHAIN) keep = E.chain(acc, cur, wr, wc, fr, fq);
        else if constexpr (!Epi::AFTER_DRAIN) E(acc, cur, wr, wc, fr, fq);
        if (!has_next) break;
        if (!keep) {
#pragma unroll
        for (int a = 0; a < 2; ++a)
#pragma unroll
            for (int b = 0; b < 2; ++b)
#pragma unroll
                for (int m = 0; m < 4; ++m)
#pragma unroll
                    for (int n = 0; n < 2; ++n) acc[a][b][m][n] = (f32x4){0.f, 0.f, 0.f, 0.f};
        }
        cur = nxt; cA = nA; cB = nB; ++ui;
        if (wr == 1) PG8_BAR;
    }
    PG8_WAIT_V(0);
    PG8_BAR;
    if constexpr (Epi::AFTER_DRAIN) E.fused(acc, cur, wr, wc, fr, fq, lds);
#undef KOFF
#undef PG8_SA
#undef PG8_SB
#undef PG8_STAGE
#undef PG8_LDA
#undef PG8_LDB
#undef PG8_MMA
#undef PG8_WAIT_V
#undef PG8_WAIT_L
#undef PG8_BAR
#undef PG8_SCHED
}

template <int ACT> __device__ __forceinline__ float actf(float v) {
    if (ACT == 1) return v * 0.125f;
    if (ACT == 2) return siluf_(v);
    if (ACT == 3) return sigmoidf_(v);
    if (ACT == 4) { const float r = fmaxf(v, 0.f); return r * r; }
    return v;
}
template <int ACT>
__device__ __forceinline__ void epi_store_bf16(const f32x4 (&acc)[2][2][4][2], bf16_t* dst, int ld, int row0, int col0) {
#pragma unroll
    for (int ai = 0; ai < 2; ++ai)
#pragma unroll
        for (int m = 0; m < 4; ++m) { bf16_t* rowp = dst + (size_t)(row0 + ai * HALF + m * 16) * ld + col0;
#pragma unroll
            for (int bj = 0; bj < 2; ++bj) { const f32x4 v0 = acc[ai][bj][m][0], v1 = acc[ai][bj][m][1];
                u32x4 w; w.x = cvt_pk_bf16(actf<ACT>(v0[0]), actf<ACT>(v0[1])); w.y = cvt_pk_bf16(actf<ACT>(v0[2]), actf<ACT>(v0[3]));
                w.z = cvt_pk_bf16(actf<ACT>(v1[0]), actf<ACT>(v1[1])); w.w = cvt_pk_bf16(actf<ACT>(v1[2]), actf<ACT>(v1[3]));
                *(u32x4*)(rowp + bj * HALF) = w; } }
}
__device__ __forceinline__ void epi_store_f32(const f32x4 (&acc)[2][2][4][2], float* dst, int ld, int row0, int col0) {
#pragma unroll
    for (int ai = 0; ai < 2; ++ai)
#pragma unroll
        for (int m = 0; m < 4; ++m) { float* rowp = dst + (size_t)(row0 + ai * HALF + m * 16) * ld + col0;
#pragma unroll
            for (int bj = 0; bj < 2; ++bj) { *(f32x4*)(rowp + bj * HALF) = acc[ai][bj][m][0]; *(f32x4*)(rowp + bj * HALF + 4) = acc[ai][bj][m][1]; } }
}

struct SchedProj {
    const char* U; const char* UC; const char* W; int G, c;
    __device__ __forceinline__ bool next(int i, Unit& u) const {
        const int L = i * G + c;
        constexpr size_t tstep = (size_t)BM * D * 2;
        if (L < 64 * 19) { int pm, pn; tile_remap(L, 64, 19, pm, pn); u.pm = pm; u.pn = pn; u.A = U + (size_t)pm * tstep; u.B = W + (size_t)pn * tstep; u.kind = 0; return true; }
        if (L < 64 * 19 + 32) { const int j = L - 64 * 19, pm = j & 7, q = j >> 3; const int pn = (q == 0) ? 5 : (q == 1) ? 6 : (q == 2) ? 7 : 18;
            u.pm = pm; u.pn = pn; u.A = UC + (size_t)pm * tstep; u.B = W + (size_t)pn * tstep; u.kind = 1; return true; }
        return false;
    }
};
struct EpiProj {
    static constexpr bool AFTER_DRAIN = false, CHAIN = false;
    unsigned char* ws;
    __device__ __forceinline__ void operator()(const f32x4 (&acc)[2][2][4][2], const Unit& u, int wr, int wc, int fr, int fq) const {
        const int row0 = u.pm * BM + wr * 64 + fr, cw = wc * 32 + 8 * fq, pn = u.pn;
        if (u.kind == 0) {
            if (pn < 4) {
                bf16_t* dst = (bf16_t*)(ws + WS_AGLU);
#pragma unroll
                for (int ai = 0; ai < 2; ++ai)
#pragma unroll
                    for (int m = 0; m < 4; ++m) { const f32x4 a0 = acc[ai][0][m][0], a1 = acc[ai][0][m][1], g0 = acc[ai][1][m][0], g1 = acc[ai][1][m][1];
                        u32x4 w; w.x = cvt_pk_f16(a0[0] * sigmoidf_(g0[0]), a0[1] * sigmoidf_(g0[1])); w.y = cvt_pk_f16(a0[2] * sigmoidf_(g0[2]), a0[3] * sigmoidf_(g0[3]));
                        w.z = cvt_pk_f16(a1[0] * sigmoidf_(g1[0]), a1[1] * sigmoidf_(g1[1])); w.w = cvt_pk_f16(a1[2] * sigmoidf_(g1[2]), a1[3] * sigmoidf_(g1[3]));
                        *(u32x4*)(dst + (size_t)(row0 + ai * HALF + m * 16) * 512 + pn * 128 + cw) = w; }
            } else if (pn == 4) epi_store_bf16<1>(acc, (bf16_t*)(ws + WS_Q), 256, row0, cw);
            else if (pn == 5) epi_store_bf16<0>(acc, (bf16_t*)(ws + WS_K), 256, row0, cw);
            else if (pn < 8) epi_store_bf16<0>(acc, (bf16_t*)(ws + WS_V), 512, row0, (pn - 6) * 256 + cw);
            else if (pn < 10) epi_store_bf16<2>(acc, (bf16_t*)(ws + WS_R), 512, row0, (pn - 8) * 256 + cw);
            else if (pn < 18) epi_store_bf16<3>(acc, (bf16_t*)(ws + WS_GATE), 2048, row0, (pn - 10) * 256 + cw);
            else { if (wc == 0) { float* dst = (float*)(ws + WS_DEC);
#pragma unroll
                    for (int ai = 0; ai < 2; ++ai)
#pragma unroll
                        for (int m = 0; m < 4; ++m) { float* rp = dst + (size_t)(row0 + ai * HALF + m * 16) * 32 + 8 * fq; *(f32x4*)rp = acc[ai][0][m][0]; *(f32x4*)(rp + 4) = acc[ai][0][m][1]; } } }
        } else {
            if (pn == 5) epi_store_bf16<0>(acc, (bf16_t*)(ws + WS_KC), 256, row0, cw);
            else if (pn < 8) epi_store_bf16<0>(acc, (bf16_t*)(ws + WS_VC), 512, row0, (pn - 6) * 256 + cw);
            else { if (wc == 0) { float* dst = (float*)(ws + WS_DECC);
#pragma unroll
                    for (int ai = 0; ai < 2; ++ai)
#pragma unroll
                        for (int m = 0; m < 4; ++m) { float* rp = dst + (size_t)(row0 + ai * HALF + m * 16) * 32 + 8 * fq; *(f32x4*)rp = acc[ai][0][m][0]; *(f32x4*)(rp + 4) = acc[ai][0][m][1]; } } }
        }
    }
};

__device__ __forceinline__ void panel_rowstat(const f32x4 (&v)[2][2][4][2], const Unit& u, int wr, int wc, int fr, int fq, LAS unsigned char* lds, float* xbuf, unsigned* cnt, unsigned* tmo) {
    const int tid = threadIdx.x;
    LAS float* Pt = (LAS float*)lds;
    LAS float* RS = (LAS float*)(lds + 4096);
#pragma unroll
    for (int ai = 0; ai < 2; ++ai)
#pragma unroll
        for (int m = 0; m < 4; ++m) { float s = 0.f;
#pragma unroll
            for (int bj = 0; bj < 2; ++bj)
#pragma unroll
                for (int n = 0; n < 2; ++n) { const f32x4 x = v[ai][bj][m][n]; s += (x[0] * x[0] + x[1] * x[1]) + (x[2] * x[2] + x[3] * x[3]); }
            s += __shfl_xor(s, 16); s += __shfl_xor(s, 32);
            if (fq == 0) Pt[(ai * HALF + wr * 64 + m * 16 + fr) * 4 + wc] = s; }
    __syncthreads();
    if (tid < 256) { const f32x4 p = *(const LAS f32x4*)(Pt + tid * 4);
        __hip_atomic_store(xbuf + ((size_t)u.pm * 256 + tid) * 4 + u.pn, (p[0] + p[1]) + (p[2] + p[3]), __ATOMIC_RELAXED, __HIP_MEMORY_SCOPE_AGENT); }
    asm volatile("s_waitcnt vmcnt(0)" ::: "memory");
    __syncthreads();
    if (tid == 0) { unsigned* cw_ = cnt + 64 * u.pm;
        (void)__hip_atomic_fetch_add(cw_, 1u, __ATOMIC_RELAXED, __HIP_MEMORY_SCOPE_AGENT);
        unsigned sp = 0;
        while (__hip_atomic_load(cw_, __ATOMIC_RELAXED, __HIP_MEMORY_SCOPE_AGENT) < 4u) { __builtin_amdgcn_s_sleep(1);
            if ((++sp & 255u) == 0u) { if (xb_ld(tmo)) break; if (sp > XB_SPIN_CAP) { atomicAdd(tmo, 1u); break; } } }
        __builtin_amdgcn_fence(__ATOMIC_ACQUIRE, "agent");
        asm volatile("s_waitcnt vmcnt(0)" ::: "memory"); }
    __syncthreads();
    if (tid < 256) { const float* xp = xbuf + ((size_t)u.pm * 256 + tid) * 4; float t = 0.f;
#pragma unroll
        for (int q = 0; q < 4; ++q) t += __hip_atomic_load(xp + q, __ATOMIC_RELAXED, __HIP_MEMORY_SCOPE_AGENT);
        RS[tid] = rsqrtf(t * (1.0f / D) + EPS); }
    __syncthreads();
}
struct EpiFinal {
    static constexpr bool AFTER_DRAIN = true, CHAIN = false;
    float* out; const bf16_t* hb; const float* mod; const float* g_post2; float* xbuf; unsigned* cnt; unsigned* tmo;
    __device__ __forceinline__ void operator()(const f32x4 (&)[2][2][4][2], const Unit&, int, int, int, int) const {}
    __device__ __forceinline__ void fused(const f32x4 (&acc)[2][2][4][2], const Unit& u, int wr, int wc, int fr, int fq, LAS unsigned char* lds) const {
        panel_rowstat(acc, u, wr, wc, fr, fq, lds, xbuf, cnt, tmo);
        const LAS float* RS = (const LAS float*)(lds + 4096);
        const int rl0 = wr * 64 + fr, col0 = u.pn * BM + wc * 32 + 8 * fq;
        const float* md = mod + (size_t)(u.pm >> 3) * (NMOD * D) + 5 * D;
        f32x4 ga[2][2];
#pragma unroll
        for (int bj = 0; bj < 2; ++bj)
#pragma unroll
            for (int n = 0; n < 2; ++n) ga[bj][n] = *(const f32x4*)(md + col0 + bj * HALF + 4 * n) * *(const f32x4*)(g_post2 + col0 + bj * HALF + 4 * n);
#pragma unroll
        for (int ai = 0; ai < 2; ++ai)
#pragma unroll
            for (int m = 0; m < 4; ++m) { const int rl = rl0 + ai * HALF + m * 16; const float rs = RS[rl];
                const size_t off = ((size_t)u.pm * BM + rl) * D + col0;
#pragma unroll
                for (int bj = 0; bj < 2; ++bj) { const u32x4 raw = __builtin_nontemporal_load((const u32x4*)(hb + off + bj * HALF));
                    const f32x4 h0 = (f32x4){bflo(raw.x), bfhi(raw.x), bflo(raw.y), bfhi(raw.y)}, h1 = (f32x4){bflo(raw.z), bfhi(raw.z), bflo(raw.w), bfhi(raw.w)};
                    *(f32x4*)(out + off + bj * HALF) = h0 + ga[bj][0] * (acc[ai][bj][m][0] * rs); *(f32x4*)(out + off + bj * HALF + 4) = h1 + ga[bj][1] * (acc[ai][bj][m][1] * rs); } }
    }
};

struct EpiMid {
    static constexpr bool AFTER_DRAIN = true, CHAIN = false;
    const float* x; bf16_t* hb; bf16_t* u2; const float* mod; const float* g_post1; const float* g_pre2; float* xbuf; unsigned* cnt; unsigned* tmo;
    __device__ __forceinline__ void operator()(const f32x4 (&)[2][2][4][2], const Unit&, int, int, int, int) const {}
    __device__ __forceinline__ void fused(f32x4 (&acc)[2][2][4][2], const Unit& u, int wr, int wc, int fr, int fq, LAS unsigned char* lds) const {
        const LAS float* RS = (const LAS float*)(lds + 4096);
        const int rl0 = wr * 64 + fr, col0 = u.pn * BM + wc * 32 + 8 * fq;
        const float* md = mod + (size_t)(u.pm >> 3) * (NMOD * D);
        panel_rowstat(acc, u, wr, wc, fr, fq, lds, xbuf, cnt, tmo);
        {
            f32x4 ga[2][2];
#pragma unroll
            for (int bj = 0; bj < 2; ++bj)
#pragma unroll
                for (int n = 0; n < 2; ++n) ga[bj][n] = *(const f32x4*)(md + 2 * D + col0 + bj * HALF + 4 * n) * *(const f32x4*)(g_post1 + col0 + bj * HALF + 4 * n);
#pragma unroll
            for (int ai = 0; ai < 2; ++ai)
#pragma unroll
                for (int m = 0; m < 4; ++m) { const int rl = rl0 + ai * HALF + m * 16; const float rs = RS[rl];
                    const size_t off = ((size_t)u.pm * BM + rl) * D + col0;
#pragma unroll
                    for (int bj = 0; bj < 2; ++bj) { const f32x4 h0 = __builtin_nontemporal_load((const f32x4*)(x + off + bj * HALF)) + ga[bj][0] * (acc[ai][bj][m][0] * rs), h1 = __builtin_nontemporal_load((const f32x4*)(x + off + bj * HALF + 4)) + ga[bj][1] * (acc[ai][bj][m][1] * rs);
                        acc[ai][bj][m][0] = h0; acc[ai][bj][m][1] = h1;
                        u32x4 w; w.x = cvt_pk_bf16(h0[0], h0[1]); w.y = cvt_pk_bf16(h0[2], h0[3]); w.z = cvt_pk_bf16(h1[0], h1[1]); w.w = cvt_pk_bf16(h1[2], h1[3]);
                        *(u32x4*)(hb + off + bj * HALF) = w; } }
        }
        __syncthreads();
        panel_rowstat(acc, u, wr, wc, fr, fq, lds, xbuf + (size_t)MTOK * 4, cnt + 4096, tmo);
        {
            f32x4 gb[2][2], gc[2][2];
#pragma unroll
            for (int bj = 0; bj < 2; ++bj)
#pragma unroll
                for (int n = 0; n < 2; ++n) { const int col = col0 + bj * HALF + 4 * n;
                    gb[bj][n] = *(const f32x4*)(g_pre2 + col) * (1.0f + *(const f32x4*)(md + 4 * D + col)); gc[bj][n] = *(const f32x4*)(md + 3 * D + col); }
#pragma unroll
            for (int ai = 0; ai < 2; ++ai)
#pragma unroll
                for (int m = 0; m < 4; ++m) { const int rl = rl0 + ai * HALF + m * 16; const float rs = RS[rl];
                    bf16_t* up = u2 + ((size_t)u.pm * BM + rl) * D + col0;
#pragma unroll
                    for (int bj = 0; bj < 2; ++bj) { const f32x4 v0 = acc[ai][bj][m][0] * rs * gb[bj][0] + gc[bj][0], v1 = acc[ai][bj][m][1] * rs * gb[bj][1] + gc[bj][1];
                        u32x4 w; w.x = cvt_pk_bf16(v0[0], v0[1]); w.y = cvt_pk_bf16(v0[2], v0[3]); w.z = cvt_pk_bf16(v1[0], v1[1]); w.w = cvt_pk_bf16(v1[2], v1[3]);
                        *(u32x4*)(up + bj * HALF) = w; } }
        }
    }
};

template <int K> struct SchedPlain {
    const char* A; const char* W; int nM, nN, G, c;
    __device__ __forceinline__ bool next(int i, Unit& u) const {
        const int L = i * G + c; if (L >= nM * nN) return false;
        constexpr size_t tstep = (size_t)BM * K * 2;
        int pm, pn; tile_remap(L, nM, nN, pm, pn); u.pm = pm; u.pn = pn; u.A = A + (size_t)pm * tstep; u.B = W + (size_t)pn * tstep; u.kind = 0; return true;
    }
};
struct SchedMerge {
    const char* A1; const char* A2; const char* W1; const char* W2; int G, c;
    __device__ __forceinline__ bool next(int i, Unit& u) const {
        const int L = (i >> 1) * G + c, sub = i & 1; if (L >= 64 * 4) return false;
        constexpr size_t tstep = (size_t)BM * 512 * 2;
        int pm, pn; tile_remap(L, 64, 4, pm, pn); u.pm = pm; u.pn = pn; u.kind = sub;
        u.A = (sub ? A2 : A1) + (size_t)pm * tstep; u.B = (sub ? W2 : W1) + (size_t)pn * tstep; return true;
    }
};
struct EpiMerge {
    static constexpr bool AFTER_DRAIN = false, CHAIN = true;
    unsigned char* ws;
    __device__ __forceinline__ void operator()(const f32x4 (&)[2][2][4][2], const Unit&, int, int, int, int) const {}
    __device__ __forceinline__ bool chain(f32x4 (&acc)[2][2][4][2], const Unit& u, int wr, int wc, int fr, int fq) const {
        const int row0 = u.pm * BM + wr * 64 + fr, col0 = u.pn * BM + wc * 32 + 8 * fq;
        const bf16_t* gate = (const bf16_t*)(ws + WS_GATE);
        bf16_t* mg = (bf16_t*)(ws + WS_MERGED);
        if (u.kind == 0) {
#pragma unroll
            for (int ai = 0; ai < 2; ++ai)
#pragma unroll
                for (int m = 0; m < 4; ++m) { const size_t row = (size_t)(row0 + ai * HALF + m * 16);
#pragma unroll
                    for (int bj = 0; bj < 2; ++bj) { const int col = col0 + bj * HALF;
                        const u32x4 g1 = __builtin_nontemporal_load((const u32x4*)(gate + row * 2048 + col)), g2 = *(const u32x4*)(gate + row * 2048 + D + col);
                        float n1[8], n2[8]; unpack8(g1, n1); unpack8(g2, n2);
#pragma unroll
                        for (int e = 0; e < 4; ++e) { acc[ai][bj][m][0][e] *= n1[e] * __builtin_amdgcn_rcpf(fmaxf(n2[e], 1e-30f)); acc[ai][bj][m][1][e] *= n1[4 + e] * __builtin_amdgcn_rcpf(fmaxf(n2[4 + e], 1e-30f)); } } }
            return true;
        }
#pragma unroll
        for (int ai = 0; ai < 2; ++ai)
#pragma unroll
            for (int m = 0; m < 4; ++m) { const size_t row = (size_t)(row0 + ai * HALF + m * 16);
#pragma unroll
                for (int bj = 0; bj < 2; ++bj) { const int col = col0 + bj * HALF;
                    const u32x4 g = __builtin_nontemporal_load((const u32x4*)(gate + row * 2048 + D + col));
                    const f32x4 v0 = acc[ai][bj][m][0], v1 = acc[ai][bj][m][1];
                    u32x4 w; w.x = cvt_pk_bf16(v0[0] * bflo(g.x), v0[1] * bfhi(g.x)); w.y = cvt_pk_bf16(v0[2] * bflo(g.y), v0[3] * bfhi(g.y));
                    w.z = cvt_pk_bf16(v1[0] * bflo(g.z), v1[1] * bfhi(g.z)); w.w = cvt_pk_bf16(v1[2] * bflo(g.w), v1[3] * bfhi(g.w));
                    *(u32x4*)(mg + row * D + col) = w; } }
        return false;
    }
};
struct EpiF32 {
    static constexpr bool AFTER_DRAIN = false, CHAIN = false;
    float* dst;
    __device__ __forceinline__ void operator()(const f32x4 (&acc)[2][2][4][2], const Unit& u, int wr, int wc, int fr, int fq) const {
        epi_store_f32(acc, dst, D, u.pm * BM + wr * 64 + fr, u.pn * BM + wc * 32 + 8 * fq);
    }
};
struct EpiBf16Plain {
    static constexpr bool AFTER_DRAIN = false, CHAIN = false;
    bf16_t* dst;
    __device__ __forceinline__ void operator()(const f32x4 (&acc)[2][2][4][2], const Unit& u, int wr, int wc, int fr, int fq) const {
        epi_store_bf16<0>(acc, dst, D, u.pm * BM + wr * 64 + fr, u.pn * BM + wc * 32 + 8 * fq);
    }
};
struct EpiRelu2 {
    static constexpr bool AFTER_DRAIN = false, CHAIN = false;
    bf16_t* dst;
    __device__ __forceinline__ void operator()(const f32x4 (&acc)[2][2][4][2], const Unit& u, int wr, int wc, int fr, int fq) const {
        epi_store_bf16<4>(acc, dst, DFF, u.pm * BM + wr * 64 + fr, u.pn * BM + wc * 32 + 8 * fq);
    }
};

__device__ __forceinline__ int win_src_base(int g) {
    const int t = g >> 3, gi = g & 7;
    if (t < 4) return (gi < 4) ? (t * 128 + gi * 32) : (512 + t * 128 + (gi - 4) * 32);
    if (t == 4) return 1024 + gi * 32;
    if (t == 5) return 1280 + gi * 32;
    if (t < 8) return 1536 + (t - 6) * 256 + gi * 32;
    if (t < 10) return 2048 + (t - 8) * 256 + gi * 32;
    if (t < 18) return 2592 + (t - 10) * 256 + gi * 32;
    return gi == 0 ? 2560 : -1;
}
__device__ __forceinline__ void transpose_item(const float* W, int K, int N, int src0, bf16_t* WT, int dst0, int k0, LAS float* scr, int lane) {
    const int c = lane & 7;
    if (src0 < 0) {
#pragma unroll
        for (int j = 0; j < 4; ++j) { const int n = (lane >> 3) + 8 * j; *(u32x4*)(WT + (size_t)(dst0 + n) * K + k0 + 8 * c) = (u32x4){0u, 0u, 0u, 0u}; }
        return;
    }
    float tmp[32];
#pragma unroll
    for (int i = 0; i < 32; ++i) { const int kk = 2 * i + (lane >> 5); tmp[i] = __builtin_nontemporal_load(W + (size_t)(k0 + kk) * N + src0 + (lane & 31)); }
#pragma unroll
    for (int i = 0; i < 32; ++i) { const int kk = 2 * i + (lane >> 5); scr[kk * 33 + (lane & 31)] = tmp[i]; }
    asm volatile("s_waitcnt lgkmcnt(0)" ::: "memory");
#pragma unroll
    for (int j = 0; j < 4; ++j) { const int n = (lane >> 3) + 8 * j; const LAS float* s = scr + (8 * c) * 33 + n;
        u32x4 o; o.x = cvt_pk_bf16(s[0 * 33], s[1 * 33]); o.y = cvt_pk_bf16(s[2 * 33], s[3 * 33]); o.z = cvt_pk_bf16(s[4 * 33], s[5 * 33]); o.w = cvt_pk_bf16(s[6 * 33], s[7 * 33]);
        *(u32x4*)(WT + (size_t)(dst0 + n) * K + k0 + 8 * c) = o; }
    asm volatile("s_waitcnt lgkmcnt(0)" ::: "memory");
}

__device__ __forceinline__ void phase0(const Params& P, LAS unsigned char* lds) {
    const int tid = threadIdx.x, lane = tid & 63, wave = tid >> 6;
    unsigned char* ws = P.ws;
    if ((int)blockIdx.x < 192) {
        LAS float* sc = (LAS float*)(lds + 80 * 1024);
        LAS float* red = (LAS float*)(lds + 80 * 1024 + 9 * 1024 * 4);
        for (int i = tid; i < 9 * 1024; i += NTHREADS) { const float v = (i < 8 * 1024) ? P.c[i] : P.c_ctx[i - 8 * 1024]; sc[i] = siluf_(v); }
        __syncthreads();
        for (int item = blockIdx.x; item < 192; item += gridDim.x) {
            const int n0 = item * 32, kg = tid >> 5, j = tid & 31;
            float a[9];
#pragma unroll
            for (int b = 0; b < 9; ++b) a[b] = 0.f;
            const float* wp = P.w_mod + (size_t)(kg * 64) * (NMOD * D) + n0 + j;
#pragma unroll 16
            for (int k = 0; k < 64; ++k) { const float w = __builtin_nontemporal_load(wp + (size_t)k * (NMOD * D));
#pragma unroll
                for (int b = 0; b < 9; ++b) a[b] += sc[b * 1024 + kg * 64 + k] * w; }
#pragma unroll
            for (int b = 0; b < 9; ++b) red[(kg * 9 + b) * 32 + j] = a[b];
            __syncthreads();
            if (tid < 288) { const int b = tid >> 5, jj = tid & 31; float s = 0.f;
#pragma unroll
                for (int g = 0; g < 16; ++g) s += red[(g * 9 + b) * 32 + jj];
                s += P.b_mod[n0 + jj];
                if (b < 8) ((float*)(ws + WS_MOD))[b * (NMOD * D) + n0 + jj] = s;
                else if (n0 + jj < 2 * D) ((float*)(ws + WS_CMOD))[n0 + jj] = s; }
            __syncthreads();
        }
    }
    LAS float* scr = (LAS float*)(lds + wave * 8448);
    const int gw = blockIdx.x * NWAVES + wave, NGW = gridDim.x * NWAVES;
    constexpr int I_IN = 16 * 152, I_F1 = 16 * 128, I_F2 = 64 * 32, I_O = 16 * 32, I_C = 8 * 32, I_G = 8 * 32;
    constexpr int NITEMS = I_IN + I_F1 + I_F2 + I_O + I_C + I_G;
    for (int it = gw; it < NITEMS; it += NGW) {
        int r = it;
        if (r < I_IN) { const int kb = r / 152, g = r % 152; transpose_item(P.w_in, D, COLEND, win_src_base(g), (bf16_t*)(ws + WS_WIN), g * 32, kb * 64, scr, lane); continue; } r -= I_IN;
        if (r < I_F1) { const int kb = r / 128, g = r % 128; transpose_item(P.w_ff1, D, DFF, g * 32, (bf16_t*)(ws + WS_WFF1), g * 32, kb * 64, scr, lane); continue; } r -= I_F1;
        if (r < I_F2) { const int kb = r / 32, g = r % 32; transpose_item(P.w_ff2, DFF, D, g * 32, (bf16_t*)(ws + WS_WFF2), g * 32, kb * 64, scr, lane); continue; } r -= I_F2;
        if (r < I_O) { const int kb = r / 32, g = r % 32; transpose_item(P.w_out, D, D, g * 32, (bf16_t*)(ws + WS_WOUT), g * 32, kb * 64, scr, lane); continue; } r -= I_O;
        if (r < I_C) { const int kb = r / 32, g = r % 32; transpose_item(P.w_conv_out, CONVD, D, g * 32, (bf16_t*)(ws + WS_WCONV), g * 32, kb * 64, scr, lane); continue; } r -= I_C;
        { const int kb = r / 32, g = r % 32; transpose_item(P.w_gla_out, 512, D, g * 32, (bf16_t*)(ws + WS_WGLA), g * 32, kb * 64, scr, lane); }
    }
}

__device__ __forceinline__ void store_row_bf16(bf16_t* orow, int lane, const f32x4 (&v)[4]) {
    u32x2* o8 = (u32x2*)orow + lane;
#pragma unroll
    for (int j = 0; j < 4; ++j) { u32x2 w; w.x = cvt_pk_bf16(v[j][0], v[j][1]); w.y = cvt_pk_bf16(v[j][2], v[j][3]); o8[64 * j] = w; }
}
__device__ __forceinline__ float sumsq4(const f32x4 (&v)[4]) {
    float s = 0.f;
#pragma unroll
    for (int j = 0; j < 4; ++j) s += (v[j][0] * v[j][0] + v[j][1] * v[j][1]) + (v[j][2] * v[j][2] + v[j][3] * v[j][3]);
    return s;
}
__device__ __forceinline__ void load_row_bf16(const bf16_t* irow, int lane, f32x4 (&v)[4]) {
    const u32x2* i8 = (const u32x2*)irow + lane;
#pragma unroll
    for (int j = 0; j < 4; ++j) { const u32x2 w = i8[64 * j]; v[j] = (f32x4){bflo(w.x), bfhi(w.x), bflo(w.y), bfhi(w.y)}; }
}
__device__ __forceinline__ void phase1(const Params& P) {
    const int lane = threadIdx.x & 63, wave = threadIdx.x >> 6;
    const int gw = blockIdx.x * NWAVES + wave, NGW = gridDim.x * NWAVES;
    const float* MOD = (const float*)(P.ws + WS_MOD); const float* CMOD = (const float*)(P.ws + WS_CMOD);
    bf16_t* U = (bf16_t*)(P.ws + WS_U); bf16_t* UC = (bf16_t*)(P.ws + WS_UC);
    for (int ch = gw; ch < MTOK / 8 + MCTX / 8; ch += NGW) {
        const bool isctx = ch >= MTOK / 8;
        const int row0 = isctx ? (ch - MTOK / 8) * 8 : ch * 8;
        const float* mod = isctx ? CMOD : MOD + (size_t)(row0 / SEQ) * (NMOD * D);
        const float* src = isctx ? P.ctx : P.x; bf16_t* dst = isctx ? UC : U;
        f32x4 sc[4], sh[4];
#pragma unroll
        for (int j = 0; j < 4; ++j) { const int col = 4 * lane + 256 * j; const f32x4 g = *(const f32x4*)(P.g_pre1 + col), s = *(const f32x4*)(mod + D + col);
            sc[j] = g * (1.0f + s); sh[j] = *(const f32x4*)(mod + col); }
        for (int r = 0; r < 8; ++r) { const size_t row = (size_t)(row0 + r);
            const f32x4* xr = (const f32x4*)(src + row * D) + lane; f32x4 v[4];
#pragma unroll
            for (int j = 0; j < 4; ++j) v[j] = __builtin_nontemporal_load(xr + 64 * j);
            const float rs = rsqrtf(wave_sum(sumsq4(v)) * (1.0f / D) + EPS);
#pragma unroll
            for (int j = 0; j < 4; ++j) v[j] = v[j] * rs * sc[j] + sh[j];
            store_row_bf16(dst + row * D, lane, v); }
    }
}
__device__ __forceinline__ void phase8(const Params& P) {
    const int lane = threadIdx.x & 63, wave = threadIdx.x >> 6;
    const int gw = blockIdx.x * NWAVES + wave, NGW = gridDim.x * NWAVES;
    const float* MOD = (const float*)(P.ws + WS_MOD); bf16_t* U = (bf16_t*)(P.ws + WS_U);
    for (int ch = gw; ch < MTOK / 8; ch += NGW) {
        const int row0 = ch * 8; const float* mod = MOD + (size_t)(row0 / SEQ) * (NMOD * D);
        f32x4 ga[4], gb[4], gc[4];
#pragma unroll
        for (int j = 0; j < 4; ++j) { const int col = 4 * lane + 256 * j;
            ga[j] = *(const f32x4*)(mod + 2 * D + col) * *(const f32x4*)(P.g_post1 + col);
            gb[j] = *(const f32x4*)(P.g_pre2 + col) * (1.0f + *(const f32x4*)(mod + 4 * D + col));
            gc[j] = *(const f32x4*)(mod + 3 * D + col); }
        for (int r = 0; r < 8; ++r) { const size_t row = (size_t)(row0 + r);
            f32x4* yr = (f32x4*)(P.out + row * D) + lane; const f32x4* xr = (const f32x4*)(P.x + row * D) + lane; f32x4 y[4], h[4];
            load_row_bf16((const bf16_t*)(P.ws + WS_Y) + row * D, lane, y);
#pragma unroll
            for (int j = 0; j < 4; ++j) h[j] = xr[64 * j];
            const float rs = rsqrtf(wave_sum(sumsq4(y)) * (1.0f / D) + EPS);
#pragma unroll
            for (int j = 0; j < 4; ++j) { h[j] = h[j] + ga[j] * (y[j] * rs); yr[64 * j] = h[j]; }
            const float rs2 = rsqrtf(wave_sum(sumsq4(h)) * (1.0f / D) + EPS);
#pragma unroll
            for (int j = 0; j < 4; ++j) h[j] = h[j] * rs2 * gb[j] + gc[j];
            store_row_bf16(U + row * D, lane, h); }
    }
}
__device__ __forceinline__ void phase11(const Params& P) {
    const int lane = threadIdx.x & 63, wave = threadIdx.x >> 6;
    const int gw = blockIdx.x * NWAVES + wave, NGW = gridDim.x * NWAVES;
    const float* MOD = (const float*)(P.ws + WS_MOD); const bf16_t* FF = (const bf16_t*)(P.ws + WS_FF2OUT);
    for (int ch = gw; ch < MTOK / 8; ch += NGW) {
        const int row0 = ch * 8; const float* mod = MOD + (size_t)(row0 / SEQ) * (NMOD * D);
        f32x4 ga[4];
#pragma unroll
        for (int j = 0; j < 4; ++j) { const int col = 4 * lane + 256 * j; ga[j] = *(const f32x4*)(mod + 5 * D + col) * *(const f32x4*)(P.g_post2 + col); }
        for (int r = 0; r < 8; ++r) { const size_t row = (size_t)(row0 + r);
            f32x4* hr = (f32x4*)(P.out + row * D) + lane; f32x4 y[4], h[4];
            load_row_bf16(FF + row * D, lane, y);
#pragma unroll
            for (int j = 0; j < 4; ++j) h[j] = hr[64 * j];
            const float rs = rsqrtf(wave_sum(sumsq4(y)) * (1.0f / D) + EPS);
#pragma unroll
            for (int j = 0; j < 4; ++j) hr[64 * j] = h[j] + ga[j] * (y[j] * rs); }
    }
}

constexpr int CV_CW = 0, CV_AT = 31 * 512 * 4;
__device__ __forceinline__ void conv_unit(const Params& P, LAS unsigned char* lds, int b, int row) {
    const int tid = threadIdx.x;
    LAS bf16_t* at = (LAS bf16_t*)(lds + CV_AT);
    const bf16_t* AG = (const bf16_t*)(P.ws + WS_AGLU);
    bf16_t* A1 = (bf16_t*)(P.ws + WS_U);
    const size_t tok0 = (size_t)b * SEQ + (size_t)row * 64;
    LAS unsigned* cwh = (LAS unsigned*)(lds + CV_CW);
    for (int i = tid; i < CK * 256; i += NTHREADS) { const f32x2 w2 = *(const f32x2*)(P.conv_w + 2 * i); cwh[i] = cvt_pk_f16(w2.x, w2.y); }
    for (int i = tid; i < 2048; i += NTHREADS) { const int t = i >> 5, ch = (i & 31) * 8; *(LAS u32x4*)(at + (t + 15) * 256 + ch) = *(const u32x4*)(AG + (tok0 + t) * 512 + ch); }
    for (int i = tid; i < 30 * 32; i += NTHREADS) { const int t = i >> 5, ch = (i & 31) * 8; *(LAS u32x4*)(at + (t < 15 ? t : t + 64) * 256 + ch) = (u32x4){0u, 0u, 0u, 0u}; }
    __syncthreads();
    const int cgp = tid & 31, wq = tid >> 5;
    h2_t ah[4][4], av[4][4];
#pragma unroll
    for (int i = 0; i < 4; ++i)
#pragma unroll
        for (int p = 0; p < 4; ++p) { ah[i][p] = (h2_t){(_Float16)0.f, (_Float16)0.f}; av[i][p] = (h2_t){(_Float16)0.f, (_Float16)0.f}; }
#pragma unroll 2
    for (int k = 0; k < CK; ++k) {
        const u32x4 wr_ = *(const LAS u32x4*)(cwh + k * 256 + cgp * 4);
        const h2_t w0 = as_h2(wr_.x), w1 = as_h2(wr_.y), w2 = as_h2(wr_.z), w3 = as_h2(wr_.w);
#pragma unroll
        for (int i = 0; i < 4; ++i) { const u32x4 raw = *(const LAS u32x4*)(at + (wq + 16 * i + k) * 256 + cgp * 8);
            ah[i][0] += as_h2(raw.x) * w0; ah[i][1] += as_h2(raw.y) * w1;
            ah[i][2] += as_h2(raw.z) * w2; ah[i][3] += as_h2(raw.w) * w3; }
    }
    {
        const int r_lo = row - 15 < 0 ? 0 : row - 15, r_hi = row + 15 > 31 ? 31 : row + 15;
        const bf16_t* srcb = AG + ((size_t)b * SEQ + wq) * 512 + 256 + cgp * 8;
#pragma unroll 4
        for (int rr = r_lo; rr <= r_hi; ++rr) { const int k = rr - row + 15;
            const u32x4 wr_ = *(const LAS u32x4*)(cwh + k * 256 + 128 + cgp * 4);
            const h2_t w0 = as_h2(wr_.x), w1 = as_h2(wr_.y), w2 = as_h2(wr_.z), w3 = as_h2(wr_.w);
            const bf16_t* src = srcb + (size_t)rr * 64 * 512;
            u32x4 raw4[4];
#pragma unroll
            for (int i = 0; i < 4; ++i) raw4[i] = *(const u32x4*)(src + (size_t)(16 * i) * 512);
#pragma unroll
            for (int i = 0; i < 4; ++i) { const u32x4 raw = raw4[i];
                av[i][0] += as_h2(raw.x) * w0; av[i][1] += as_h2(raw.y) * w1;
                av[i][2] += as_h2(raw.z) * w2; av[i][3] += as_h2(raw.w) * w3; }
        }
    }
    float yh[4][8], yv[4][8];
    {
        const f32x4 b0 = *(const f32x4*)(P.conv_b + cgp * 8), b1 = *(const f32x4*)(P.conv_b + cgp * 8 + 4);
        const f32x4 c0 = *(const f32x4*)(P.conv_b + 256 + cgp * 8), c1 = *(const f32x4*)(P.conv_b + 256 + cgp * 8 + 4);
#pragma unroll
        for (int i = 0; i < 4; ++i)
#pragma unroll
            for (int p = 0; p < 4; ++p) { const float bh_lo = (p < 2) ? b0[2 * (p & 1)] : b1[2 * (p & 1)], bh_hi = (p < 2) ? b0[2 * (p & 1) + 1] : b1[2 * (p & 1) + 1];
                const float bv_lo = (p < 2) ? c0[2 * (p & 1)] : c1[2 * (p & 1)], bv_hi = (p < 2) ? c0[2 * (p & 1) + 1] : c1[2 * (p & 1) + 1];
                yh[i][2 * p] = (float)ah[i][p].x + bh_lo; yh[i][2 * p + 1] = (float)ah[i][p].y + bh_hi;
                yv[i][2 * p] = (float)av[i][p].x + bv_lo; yv[i][2 * p + 1] = (float)av[i][p].y + bv_hi; }
    }
    const f32x4 gh0 = *(const f32x4*)(P.conv_ln_g + cgp * 8), gh1 = *(const f32x4*)(P.conv_ln_g + cgp * 8 + 4), bh0 = *(const f32x4*)(P.conv_ln_b + cgp * 8), bh1 = *(const f32x4*)(P.conv_ln_b + cgp * 8 + 4);
    const f32x4 gv0 = *(const f32x4*)(P.conv_ln_g + 256 + cgp * 8), gv1 = *(const f32x4*)(P.conv_ln_g + 256 + cgp * 8 + 4), bv0 = *(const f32x4*)(P.conv_ln_b + 256 + cgp * 8), bv1 = *(const f32x4*)(P.conv_ln_b + 256 + cgp * 8 + 4);
#pragma unroll
    for (int i = 0; i < 4; ++i) {
        float s1 = 0.f, s2 = 0.f;
#pragma unroll
        for (int e = 0; e < 8; ++e) { s1 += yh[i][e] + yv[i][e]; s2 += yh[i][e] * yh[i][e] + yv[i][e] * yv[i][e]; }
#pragma unroll
        for (int o = 1; o < 32; o <<= 1) { s1 += __shfl_xor(s1, o); s2 += __shfl_xor(s2, o); }
        const float mean = s1 * (1.0f / 512.f), var = fmaxf(s2 * (1.0f / 512.f) - mean * mean, 0.f), rstd = rsqrtf(var + EPS);
        float oh[8], ov[8];
#pragma unroll
        for (int e = 0; e < 4; ++e) {
            oh[e] = siluf_((yh[i][e] - mean) * rstd * gh0[e] + bh0[e]); oh[4 + e] = siluf_((yh[i][4 + e] - mean) * rstd * gh1[e] + bh1[e]);
            ov[e] = siluf_((yv[i][e] - mean) * rstd * gv0[e] + bv0[e]); ov[4 + e] = siluf_((yv[i][4 + e] - mean) * rstd * gv1[e] + bv1[e]); }
        bf16_t* dst = A1 + (tok0 + wq + 16 * i) * 512 + cgp * 8;
        u32x4 w; w.x = cvt_pk_bf16(oh[0], oh[1]); w.y = cvt_pk_bf16(oh[2], oh[3]); w.z = cvt_pk_bf16(oh[4], oh[5]); w.w = cvt_pk_bf16(oh[6], oh[7]);
        *(u32x4*)dst = w;
        w.x = cvt_pk_bf16(ov[0], ov[1]); w.y = cvt_pk_bf16(ov[2], ov[3]); w.z = cvt_pk_bf16(ov[4], ov[5]); w.w = cvt_pk_bf16(ov[6], ov[7]);
        *(u32x4*)(dst + 256) = w;
    }
    __syncthreads();
}

constexpr int GL_G = 0;
constexpr int GL_Z = 33792;
constexpr int GL_WD = GL_Z + 8192;
constexpr int GL_BD = GL_WD + 8192;
constexpr int GL_TOT = GL_BD + 512;
constexpr int GL_QC = GL_TOT + 2048;
constexpr int GL_KF = GL_QC + 64 * 136 * 2;
constexpr int GL_KB = GL_KF + 64 * 72 * 2;
constexpr int GL_VT = GL_KB + 64 * 72 * 2;
constexpr int GL_AS = GL_VT + 128 * 72 * 2;
constexpr int GL_SC = GL_AS + 64 * 72 * 2;
constexpr int GL_END = GL_SC + 128 * 136 * 2;
static_assert(GL_END <= LDS_BYTES, "gla lds");

__device__ __forceinline__ float log_sigmoid_(float x) { return fminf(x, 0.f) - __logf(1.0f + __expf(-fabsf(x))); }

__device__ __forceinline__ void vt_write(LAS bf16_t* VT, int t, int v8, const u32x4 vv) {
    VT[(v8 + 0) * 72 + t] = (bf16_t)(vv.x & 0xffff); VT[(v8 + 1) * 72 + t] = (bf16_t)(vv.x >> 16); VT[(v8 + 2) * 72 + t] = (bf16_t)(vv.y & 0xffff); VT[(v8 + 3) * 72 + t] = (bf16_t)(vv.y >> 16);
    VT[(v8 + 4) * 72 + t] = (bf16_t)(vv.z & 0xffff); VT[(v8 + 5) * 72 + t] = (bf16_t)(vv.z >> 16); VT[(v8 + 6) * 72 + t] = (bf16_t)(vv.w & 0xffff); VT[(v8 + 7) * 72 + t] = (bf16_t)(vv.w >> 16);
}
struct LocalRegs { f32x4 z, wd; float bd; u32x4 k, v[2]; };
__device__ __forceinline__ void gla_local_load(const Params& P, int b, int h, int idx, LocalRegs& R) {
    const int tid = threadIdx.x; unsigned char* ws = P.ws;
    const bool isctx = idx < 4;
    const size_t tok0 = isctx ? (size_t)b * CTXL + (size_t)idx * 64 : (size_t)b * SEQ + (size_t)(idx - 4) * 64;
    const float* zsrc = (const float*)(ws + (isctx ? WS_DECC : WS_DEC)) + tok0 * 32;
    const bf16_t* ksrc = (const bf16_t*)(ws + (isctx ? WS_KC : WS_K)) + tok0 * 256 + h * 64;
    const bf16_t* vsrc = (const bf16_t*)(ws + (isctx ? WS_VC : WS_V)) + tok0 * 512 + h * 128;
    R.z = ((const f32x4*)zsrc)[tid];
    { const int i4 = tid * 4, dir = i4 >> 10, r = (i4 >> 6) & 15, d = i4 & 63; R.wd = *(const f32x4*)(P.w_decay + (size_t)(dir * 16 + r) * 256 + h * 64 + d); }
    R.bd = (tid < 128) ? P.b_decay[(tid >> 6) * 256 + h * 64 + (tid & 63)] : 0.f;
    R.k = *(const u32x4*)(ksrc + (size_t)(tid & 63) * 256 + (tid >> 6) * 8);
#pragma unroll
    for (int i = 0; i < 2; ++i) { const int ix = tid + 512 * i; R.v[i] = *(const u32x4*)(vsrc + (size_t)(ix & 63) * 512 + (ix >> 6) * 8); }
}
__device__ __forceinline__ void gla_local_unit(const Params& P, LAS unsigned char* lds, int b, int h, int idx, const LocalRegs& R) {
    const int tid = threadIdx.x, lane = tid & 63, wave = tid >> 6, fr = lane & 15, fq = lane >> 4;
    unsigned char* ws = P.ws;
    const bool isctx = idx < 4;
    LAS float* Z = (LAS float*)(lds + GL_Z); LAS float* WD = (LAS float*)(lds + GL_WD); LAS float* BD = (LAS float*)(lds + GL_BD);
    LAS float* TOT = (LAS float*)(lds + GL_TOT); LAS float* G = (LAS float*)(lds + GL_G);
    LAS bf16_t* KF = (LAS bf16_t*)(lds + GL_KF); LAS bf16_t* KB = (LAS bf16_t*)(lds + GL_KB); LAS bf16_t* VT = (LAS bf16_t*)(lds + GL_VT);
    const f32x4 zreg = R.z, wdreg = R.wd; const float bdreg = R.bd; const u32x4 kreg = R.k; u32x4 vreg[2] = {R.v[0], R.v[1]};
    const int kt = tid & 63, kd8 = (tid >> 6) * 8;
    ((LAS f32x4*)Z)[tid] = zreg; ((LAS f32x4*)WD)[tid] = wdreg; if (tid < 128) BD[tid] = bdreg;
    __syncthreads();
    {
        const int dir = tid >> 8, q4 = (tid >> 6) & 3, d = tid & 63;
        f32x2 w2[8]; float la[16];
#pragma unroll
        for (int r = 0; r < 8; ++r) w2[r] = (f32x2){WD[(dir * 16 + 2 * r) * 64 + d], WD[(dir * 16 + 2 * r + 1) * 64 + d]};
        const float bias = BD[dir * 64 + d];
#pragma unroll
        for (int j = 0; j < 16; ++j) { const LAS f32x4* zp = (const LAS f32x4*)(Z + (q4 * 16 + j) * 32 + dir * 16); f32x2 a2 = (f32x2){bias, 0.f};
#pragma unroll
            for (int r4 = 0; r4 < 4; ++r4) { const f32x4 z = zp[r4]; a2 += (f32x2){z[0], z[1]} * w2[2 * r4]; a2 += (f32x2){z[2], z[3]} * w2[2 * r4 + 1]; }
            la[j] = log_sigmoid_(a2.x + a2.y) * (1.0f / 16.0f); }
        float tot;
        if (dir == 0) {
#pragma unroll
            for (int j = 1; j < 16; ++j) la[j] += la[j - 1];
            tot = la[15];
        } else {
#pragma unroll
            for (int j = 14; j >= 0; --j) la[j] += la[j + 1];
            tot = la[0];
        }
        TOT[(dir * 4 + q4) * 64 + d] = tot;
        __syncthreads();
        float off = 0.f;
#pragma unroll
        for (int q = 0; q < 4; ++q) { const float tq = TOT[(dir * 4 + q) * 64 + d]; if (dir == 0 ? (q < q4) : (q > q4)) off += tq; }
        _Float16* gb = (_Float16*)P.out + ((size_t)(b * 4 + h) * 32 + (idx - 4)) * 8192;
#pragma unroll
        for (int j = 0; j < 16; ++j) { const float g = la[j] + off; G[(dir * 64 + d) * 65 + q4 * 16 + j] = g; if (!isctx) gb[(dir * 64 + q4 * 16 + j) * 64 + d] = (_Float16)g; }
    }
    __syncthreads();
    { float kf[8]; unpack8(kreg, kf);
#pragma unroll
      for (int e = 0; e < 8; ++e) { const int d = kd8 + e; const float gf = G[d * 65 + kt], gfl = G[d * 65 + 63], gb_ = G[(64 + d) * 65 + kt], gb0 = G[(64 + d) * 65];
          KF[d * 72 + kt] = f2bf(kf[e] * __expf(gfl - gf)); KB[d * 72 + kt] = f2bf(kf[e] * __expf(gb0 - gb_)); } }
#pragma unroll
    for (int i = 0; i < 2; ++i) { const int ix = tid + 512 * i; vt_write(VT, ix & 63, (ix >> 6) * 8, vreg[i]); }
    const size_t chain0 = (size_t)(0 * 32 + b * 4 + h) * NCH + idx, chain1 = (size_t)(1 * 32 + b * 4 + h) * NCH + idx;
    if (tid < 128) { const int dir = tid >> 6, d = tid & 63; float* dv = (float*)(ws + WS_DVEC) + (dir ? chain1 : chain0) * 64;
        dv[d] = __expf(dir == 0 ? G[d * 65 + 63] : G[(64 + d) * 65]); }
    __syncthreads();
    { const int dir = wave >> 2, db = wave & 3; const LAS bf16_t* KD = dir ? KB : KF;
      bf16x8 aq[2];
#pragma unroll
      for (int kk = 0; kk < 2; ++kk) aq[kk] = *(const LAS bf16x8*)(KD + (16 * db + fr) * 72 + 32 * kk + 8 * fq);
      bf16_t* sb = (bf16_t*)(ws + WS_G) + (dir ? chain1 : chain0) * 8192;
#pragma unroll
      for (int vb = 0; vb < 8; ++vb) { f32x4 acc = (f32x4){0.f, 0.f, 0.f, 0.f};
#pragma unroll
          for (int kk = 0; kk < 2; ++kk) { const bf16x8 bq = *(const LAS bf16x8*)(VT + (16 * vb + fr) * 72 + 32 * kk + 8 * fq); acc = __builtin_amdgcn_mfma_f32_16x16x32_bf16(aq[kk], bq, acc, 0, 0, 0); }
          u32x2 w2; w2.x = cvt_pk_bf16(acc[0], acc[1]); w2.y = cvt_pk_bf16(acc[2], acc[3]);
          *(u32x2*)(sb + (16 * vb + fr) * 64 + 16 * db + 4 * fq) = w2; } }
}
__device__ __forceinline__ void gla_scan_phase(const Params& P) {
    const int gt = blockIdx.x * NTHREADS + threadIdx.x, NT = gridDim.x * NTHREADS;
    for (int id = gt; id < 64 * 4096; id += NT) {
        const int chain = id >> 12, e2 = id & 4095, dir = chain >> 5, d = (2 * e2) & 63;
        unsigned* base = (unsigned*)(P.ws + WS_G) + (size_t)chain * NCH * 4096 + e2;
        const float* dv = (const float*)(P.ws + WS_DVEC) + (size_t)chain * NCH * 64 + d;
        unsigned L[NCH]; f32x2 dd[NCH];
#pragma unroll
        for (int step = 0; step < NCH; ++step) { const int idx = (dir == 0) ? step : (step < 4 ? 3 - step : 39 - step);
            L[step] = __builtin_nontemporal_load(base + (size_t)idx * 4096); dd[step] = *(const f32x2*)(dv + idx * 64); }
        float s0 = 0.f, s1 = 0.f;
#pragma unroll
        for (int step = 0; step < NCH; ++step) { const int idx = (dir == 0) ? step : (step < 4 ? 3 - step : 39 - step);
            if (step >= 4) base[(size_t)idx * 4096] = cvt_pk_bf16(s0, s1);
            s0 = dd[step].x * s0 + bflo(L[step]); s1 = dd[step].y * s1 + bfhi(L[step]); }
    }
}
struct OutRegs { u32x4 gfh, gbh; u32x4 q, k, v[2], sf[2], sb[2]; unsigned r[8]; };
__device__ __forceinline__ void gla_out_load(const Params& P, int b, int h, int c, OutRegs& R) {
    const int tid = threadIdx.x, lane = tid & 63, wave = tid >> 6; unsigned char* ws = P.ws;
    const size_t tok0 = (size_t)b * SEQ + (size_t)c * 64;
    const bf16_t* qsrc = (const bf16_t*)(ws + WS_Q) + tok0 * 256 + h * 64;
    const bf16_t* ksrc = (const bf16_t*)(ws + WS_K) + tok0 * 256 + h * 64;
    const bf16_t* vsrc = (const bf16_t*)(ws + WS_V) + tok0 * 512 + h * 128;
    const _Float16* gsrc = (const _Float16*)P.out + ((size_t)(b * 4 + h) * 32 + c) * 8192;
    const bf16_t* sf = (const bf16_t*)(ws + WS_G) + ((size_t)(b * 4 + h) * NCH + 4 + c) * 8192;
    const bf16_t* sbk = (const bf16_t*)(ws + WS_G) + ((size_t)(32 + b * 4 + h) * NCH + 4 + c) * 8192;
    const bf16_t* RB = (const bf16_t*)(ws + WS_R);
    const int t = tid >> 3, d8 = (tid & 7) * 8;
    R.gfh = __builtin_nontemporal_load((const u32x4*)(gsrc + t * 64 + d8)); R.gbh = __builtin_nontemporal_load((const u32x4*)(gsrc + (64 + t) * 64 + d8));
    R.q = __builtin_nontemporal_load((const u32x4*)(qsrc + (size_t)t * 256 + d8)); R.k = __builtin_nontemporal_load((const u32x4*)(ksrc + (size_t)t * 256 + d8));
#pragma unroll
    for (int i = 0; i < 2; ++i) { const int ix = tid + 512 * i; R.v[i] = __builtin_nontemporal_load((const u32x4*)(vsrc + (size_t)(ix & 63) * 512 + (ix >> 6) * 8));
        R.sf[i] = __builtin_nontemporal_load((const u32x4*)(sf + (ix >> 3) * 64 + (ix & 7) * 8)); R.sb[i] = __builtin_nontemporal_load((const u32x4*)(sbk + (ix >> 3) * 64 + (ix & 7) * 8)); }
#pragma unroll
    for (int i = 0; i < 8; ++i) R.r[i] = __builtin_nontemporal_load((const unsigned*)(RB + (tok0 + wave * 8 + i) * 512 + h * 128 + 2 * lane));
}
__device__ __forceinline__ void gla_out_unit(const Params& P, LAS unsigned char* lds, int b, int h, int c, const OutRegs& R) {
    const int tid = threadIdx.x, lane = tid & 63, wave = tid >> 6, fr = lane & 15, fq = lane >> 4;
    unsigned char* ws = P.ws;
    const size_t tok0 = (size_t)b * SEQ + (size_t)c * 64;
    LAS bf16_t* QC = (LAS bf16_t*)(lds + GL_QC); LAS bf16_t* KF = (LAS bf16_t*)(lds + GL_KF); LAS bf16_t* KB = (LAS bf16_t*)(lds + GL_KB);
    LAS bf16_t* VT = (LAS bf16_t*)(lds + GL_VT); LAS bf16_t* AS = (LAS bf16_t*)(lds + GL_AS); LAS bf16_t* SC = (LAS bf16_t*)(lds + GL_SC);
    const int t = tid >> 3, d8 = (tid & 7) * 8;
    const u32x4 qreg = R.q, kreg = R.k;
    float gfa[8], gba[8];
    { const unsigned f0 = R.gfh.x, f1 = R.gfh.y, f2 = R.gfh.z, f3 = R.gfh.w, b0 = R.gbh.x, b1 = R.gbh.y, b2 = R.gbh.z, b3 = R.gbh.w;
      const h2_t hf0 = as_h2(f0), hf1 = as_h2(f1), hf2 = as_h2(f2), hf3 = as_h2(f3), hb0 = as_h2(b0), hb1 = as_h2(b1), hb2 = as_h2(b2), hb3 = as_h2(b3);
      gfa[0] = (float)hf0.x; gfa[1] = (float)hf0.y; gfa[2] = (float)hf1.x; gfa[3] = (float)hf1.y; gfa[4] = (float)hf2.x; gfa[5] = (float)hf2.y; gfa[6] = (float)hf3.x; gfa[7] = (float)hf3.y;
      gba[0] = (float)hb0.x; gba[1] = (float)hb0.y; gba[2] = (float)hb1.x; gba[3] = (float)hb1.y; gba[4] = (float)hb2.x; gba[5] = (float)hb2.y; gba[6] = (float)hb3.x; gba[7] = (float)hb3.y; }
    u32x4 vreg[2] = {R.v[0], R.v[1]}, sfr[2] = {R.sf[0], R.sf[1]}, sbr[2] = {R.sb[0], R.sb[1]};
    unsigned rreg[8];
#pragma unroll
    for (int i = 0; i < 8; ++i) rreg[i] = R.r[i];
    { float qf[8], kf[8]; unpack8(qreg, qf); unpack8(kreg, kf);
      float a[8], bb[8], cc[8], dd[8];
#pragma unroll
      for (int e = 0; e < 8; ++e) { const float gf = gfa[e], gb = gba[e];
          a[e] = qf[e] * __expf(gf); bb[e] = qf[e] * __expf(gb); cc[e] = kf[e] * __expf(-gf); dd[e] = kf[e] * __expf(-gb); }
      u32x4 w;
      w.x = cvt_pk_bf16(a[0], a[1]); w.y = cvt_pk_bf16(a[2], a[3]); w.z = cvt_pk_bf16(a[4], a[5]); w.w = cvt_pk_bf16(a[6], a[7]); *(LAS u32x4*)(QC + t * 136 + d8) = w;
      w.x = cvt_pk_bf16(bb[0], bb[1]); w.y = cvt_pk_bf16(bb[2], bb[3]); w.z = cvt_pk_bf16(bb[4], bb[5]); w.w = cvt_pk_bf16(bb[6], bb[7]); *(LAS u32x4*)(QC + t * 136 + 64 + d8) = w;
      w.x = cvt_pk_bf16(cc[0], cc[1]); w.y = cvt_pk_bf16(cc[2], cc[3]); w.z = cvt_pk_bf16(cc[4], cc[5]); w.w = cvt_pk_bf16(cc[6], cc[7]); *(LAS u32x4*)(KF + t * 72 + d8) = w;
      w.x = cvt_pk_bf16(dd[0], dd[1]); w.y = cvt_pk_bf16(dd[2], dd[3]); w.z = cvt_pk_bf16(dd[4], dd[5]); w.w = cvt_pk_bf16(dd[6], dd[7]); *(LAS u32x4*)(KB + t * 72 + d8) = w; }
#pragma unroll
    for (int i = 0; i < 2; ++i) { const int ix = tid + 512 * i; vt_write(VT, ix & 63, (ix >> 6) * 8, vreg[i]);
        *(LAS u32x4*)(SC + (ix >> 3) * 136 + (ix & 7) * 8) = sfr[i]; *(LAS u32x4*)(SC + (ix >> 3) * 136 + 64 + (ix & 7) * 8) = sbr[i]; }
    __syncthreads();
    { const int tb = wave >> 1;
#pragma unroll
      for (int s2 = 0; s2 < 2; ++s2) { const int sb = 2 * (wave & 1) + s2;
          f32x4 af = (f32x4){0.f, 0.f, 0.f, 0.f}, ab = (f32x4){0.f, 0.f, 0.f, 0.f};
          if (tb >= sb) {
#pragma unroll
              for (int kk = 0; kk < 2; ++kk) { const bf16x8 aq = *(const LAS bf16x8*)(QC + (16 * tb + fr) * 136 + 32 * kk + 8 * fq), bq = *(const LAS bf16x8*)(KF + (16 * sb + fr) * 72 + 32 * kk + 8 * fq);
                  af = __builtin_amdgcn_mfma_f32_16x16x32_bf16(aq, bq, af, 0, 0, 0); } }
          if (tb <= sb) {
#pragma unroll
              for (int kk = 0; kk < 2; ++kk) { const bf16x8 aq = *(const LAS bf16x8*)(QC + (16 * tb + fr) * 136 + 64 + 32 * kk + 8 * fq), bq = *(const LAS bf16x8*)(KB + (16 * sb + fr) * 72 + 32 * kk + 8 * fq);
                  ab = __builtin_amdgcn_mfma_f32_16x16x32_bf16(aq, bq, ab, 0, 0, 0); } }
#pragma unroll
          for (int r = 0; r < 4; ++r) { const int tt = 16 * tb + 4 * fq + r, s = 16 * sb + fr; const float val = (s <= tt ? af[r] : 0.f) + (s >= tt ? ab[r] : 0.f); AS[tt * 72 + s] = f2bf(val); } } }
    __syncthreads();
    { const int tb = wave >> 1; LAS float* OB = (LAS float*)(lds + GL_G);
      bf16x8 aas[2], aqc[4];
#pragma unroll
      for (int kk = 0; kk < 2; ++kk) aas[kk] = *(const LAS bf16x8*)(AS + (16 * tb + fr) * 72 + 32 * kk + 8 * fq);
#pragma unroll
      for (int kk = 0; kk < 4; ++kk) aqc[kk] = *(const LAS bf16x8*)(QC + (16 * tb + fr) * 136 + 32 * kk + 8 * fq);
#pragma unroll
      for (int v4 = 0; v4 < 4; ++v4) { const int vb = 4 * (wave & 1) + v4; f32x4 acc = (f32x4){0.f, 0.f, 0.f, 0.f};
#pragma unroll
          for (int kk = 0; kk < 2; ++kk) { const bf16x8 bq = *(const LAS bf16x8*)(VT + (16 * vb + fr) * 72 + 32 * kk + 8 * fq); acc = __builtin_amdgcn_mfma_f32_16x16x32_bf16(aas[kk], bq, acc, 0, 0, 0); }
#pragma unroll
          for (int kk = 0; kk < 4; ++kk) { const bf16x8 bq = *(const LAS bf16x8*)(SC + (16 * vb + fr) * 136 + 32 * kk + 8 * fq); acc = __builtin_amdgcn_mfma_f32_16x16x32_bf16(aqc[kk], bq, acc, 0, 0, 0); }
#pragma unroll
          for (int r = 0; r < 4; ++r) OB[(16 * tb + 4 * fq + r) * 132 + 16 * vb + fr] = acc[r]; } }
    __syncthreads();
    { const LAS float* OB = (const LAS float*)(lds + GL_G); bf16_t* A2 = (bf16_t*)(ws + WS_U) + (size_t)MTOK * 512;
      const f32x2 g = *(const f32x2*)(P.gla_norm_g + 2 * lane);
#pragma unroll
      for (int i = 0; i < 8; ++i) { const int tt = wave * 8 + i; const f32x2 o = *(const LAS f32x2*)(OB + tt * 132 + 2 * lane);
          const float rs = rsqrtf(wave_sum(o.x * o.x + o.y * o.y) * (1.0f / 128.f) + EPS);
          *(unsigned*)(A2 + (tok0 + tt) * 512 + h * 128 + 2 * lane) = cvt_pk_bf16(o.x * rs * g.x * bflo(rreg[i]), o.y * rs * g.y * bfhi(rreg[i])); } }
}

#define XB_TMO      128
#define XB_XCNT(j)  (256  + 64 * (j))
#define XB_XSUB(j)  (1280 + 64 * (j))
#define XB_XGEN(j)  (2304 + 64 * (j))
#define XB_TOP      3328
#define XB_TOPGEN   3392
__device__ __forceinline__ unsigned xb_add(unsigned* p, unsigned v) { return __hip_atomic_fetch_add(p, v, __ATOMIC_RELAXED, __HIP_MEMORY_SCOPE_AGENT); }
__device__ __forceinline__ unsigned xb_xcc_id() { return (unsigned)__builtin_amdgcn_s_getreg((3 << 11) | 20) & 0xFu; }
#define XB_SPIN(cond, bar) do { unsigned _sp = 0; while (cond) { __builtin_amdgcn_s_sleep(1); \
    if ((++_sp & 255u) == 0u) { if (xb_ld(&(bar)[XB_TMO])) break; if (_sp > XB_SPIN_CAP) { atomicAdd(&(bar)[XB_TMO], 1u); break; } } } } while (0)
struct XcdBarrier { unsigned* bar; unsigned x; volatile LAS unsigned* st; };
__device__ __forceinline__ XcdBarrier xcd_barrier_post(unsigned* bar, volatile LAS unsigned* st) {
    XcdBarrier b; b.bar = bar; b.x = xb_xcc_id(); b.st = st;
    if (threadIdx.x == 0) (void)xb_add(&bar[XB_XCNT(b.x)], 1u);
    return b;
}
__device__ __forceinline__ void xcd_barrier_complete(unsigned* bar, unsigned x, unsigned& nloc, unsigned& nx) {
    const unsigned G = gridDim.x * gridDim.y * gridDim.z;
    unsigned sum, cnt, mine, sp = 0u;
    for (;;) {
        sum = 0u; cnt = 0u; mine = 0u;
#pragma unroll
        for (unsigned j = 0; j < 16; ++j) { const unsigned c = xb_ld(&bar[XB_XCNT(j)]); sum += c; cnt += (c > 0u) ? 1u : 0u; mine = (j == x) ? c : mine; }
        if (sum == G) break;
        __builtin_amdgcn_s_sleep(1);
        if ((++sp & 255u) == 0u) { if (xb_ld(&bar[XB_TMO])) break; if (sp > XB_SPIN_CAP) { atomicAdd(&bar[XB_TMO], 1u); break; } }
    }
    nloc = mine > 0u ? mine : 1u; nx = cnt > 0u ? cnt : 1u;
}
__device__ __forceinline__ void xcd_barrier(const XcdBarrier& b) {
    asm volatile("s_waitcnt vmcnt(0)" ::: "memory");
    __syncthreads();
    if (threadIdx.x == 0) {
        unsigned* bar = b.bar;
        __builtin_amdgcn_s_waitcnt(0);
        unsigned nloc = b.st[0], nx = b.st[1];
        if (nloc == 0u) { xcd_barrier_complete(bar, b.x, nloc, nx); b.st[0] = nloc; b.st[1] = nx; }
        const unsigned old = xb_add(&bar[XB_XSUB(b.x)], 1u);
        const unsigned gen = old / nloc;
        if (old + 1u == (gen + 1u) * nloc) {
            __builtin_amdgcn_fence(__ATOMIC_RELEASE, "agent");
            asm volatile("s_waitcnt vmcnt(0)" ::: "memory");
            const unsigned og = xb_add(&bar[XB_TOP], 1u);
            const unsigned tg = og / nx;
            if (og + 1u == (tg + 1u) * nx) xb_add(&bar[XB_TOPGEN], 1u);
            else XB_SPIN(xb_ld(&bar[XB_TOPGEN]) == tg, bar);
            __builtin_amdgcn_fence(__ATOMIC_ACQUIRE, "agent");
            xb_add(&bar[XB_XGEN(b.x)], 1u);
            asm volatile("s_waitcnt vmcnt(0)" ::: "memory");
        } else {
            XB_SPIN(xb_ld(&bar[XB_XGEN(b.x)]) == gen, bar);
            __builtin_amdgcn_fence(__ATOMIC_ACQUIRE, "agent");
            asm volatile("s_waitcnt vmcnt(0)" ::: "memory");
        }
    }
    __syncthreads();
}

__global__ void __launch_bounds__(NTHREADS, 2) fwd_megakernel(Params P) {
    extern __shared__ __attribute__((aligned(16))) unsigned char lds_raw[];
    LAS unsigned char* lds = (LAS unsigned char*)lds_raw;
    cg::grid_group grid = cg::this_grid();
    const int lo = P.ph_lo, hi = P.ph_hi;
    const int G = gridDim.x, c = blockIdx.x;
    unsigned char* ws = P.ws;
#define IN(k) (lo <= (k) && (k) < hi)
    volatile LAS unsigned* xst = (volatile LAS unsigned*)(lds + LDS_BYTES - 16);
    if (threadIdx.x < 4) xst[threadIdx.x] = 0u;
    __syncthreads();
    XcdBarrier xb = xcd_barrier_post((unsigned*)(ws + WS_BAR), xst);
    if (P.ph_hi == 12345) grid.sync();
#define SEAM(k) do { if (IN((k) + 1)) xcd_barrier(xb); } while (0)
    if (IN(0)) { phase0(P, lds); SEAM(0); }
    if (IN(1)) { phase1(P); SEAM(1); }
    if (IN(2)) { SchedProj S{(const char*)(ws + WS_U), (const char*)(ws + WS_UC), (const char*)(ws + WS_WIN), G, c}; EpiProj E{ws};
        gemm_phase<D, SchedProj, EpiProj>(lds, S, E); SEAM(2); }
    if (IN(3)) {
        { LocalRegs R0, R1; int u = c; bool have = u < NB * NH * NCH;
          if (have) gla_local_load(P, (u / NCH) >> 2, (u / NCH) & 3, u % NCH, R0);
          for (int uc = c; uc < NB * 32; uc += G) conv_unit(P, lds, uc & 7, uc >> 3);
          while (have) { const int un = u + G; const bool hn = un < NB * NH * NCH;
              if (hn) gla_local_load(P, (un / NCH) >> 2, (un / NCH) & 3, un % NCH, R1);
              gla_local_unit(P, lds, (u / NCH) >> 2, (u / NCH) & 3, u % NCH, R0);
              R0 = R1; u = un; have = hn; } }
        SEAM(3); }
    if (IN(4)) { gla_scan_phase(P); SEAM(4); }
    if (IN(5)) {
        { OutRegs R0, R1; int u = c; bool have = u < NB * NH * 32;
          if (have) gla_out_load(P, (u >> 5) >> 2, (u >> 5) & 3, u & 31, R0);
          while (have) { const int un = u + G; const bool hn = un < NB * NH * 32;
              if (hn) gla_out_load(P, (un >> 5) >> 2, (un >> 5) & 3, un & 31, R1);
              gla_out_unit(P, lds, (u >> 5) >> 2, (u >> 5) & 3, u & 31, R0);
              R0 = R1; u = un; have = hn; } }
        SEAM(5); }
    if (IN(6)) { SchedMerge S{(const char*)(ws + WS_U), (const char*)(ws + WS_U) + (size_t)MTOK * 512 * 2, (const char*)(ws + WS_WCONV), (const char*)(ws + WS_WGLA), G, c}; EpiMerge E{ws};
        gemm_phase<512, SchedMerge, EpiMerge>(lds, S, E); SEAM(6); }
    if (IN(7)) { SchedPlain<D> S{(const char*)(ws + WS_MERGED), (const char*)(ws + WS_WOUT), 64, 4, G, c};
        if (G == 256) {
            EpiMid E{P.x, (bf16_t*)(ws + WS_Y), (bf16_t*)(ws + WS_U), (const float*)(ws + WS_MOD), P.g_post1, P.g_pre2, (float*)(ws + WS_XBUF) + (size_t)MTOK * 4, (unsigned*)(ws + WS_XCNT) + 4096, (unsigned*)(ws + WS_BAR) + XB_TMO};
            gemm_phase<D, SchedPlain<D>, EpiMid>(lds, S, E); SEAM(8);
        } else { EpiBf16Plain E{(bf16_t*)(ws + WS_Y)};
            gemm_phase<D, SchedPlain<D>, EpiBf16Plain>(lds, S, E); SEAM(7); } }
    if (IN(8) && G != 256) { phase8(P); SEAM(8); }
    if (IN(9)) { SchedPlain<D> S{(const char*)(ws + WS_U), (const char*)(ws + WS_WFF1), 64, 16, G, c}; EpiRelu2 E{(bf16_t*)(ws + WS_FFACT)};
        gemm_phase<D, SchedPlain<D>, EpiRelu2>(lds, S, E); SEAM(9); }
    if (IN(10)) { SchedPlain<DFF> S{(const char*)(ws + WS_FFACT), (const char*)(ws + WS_WFF2), 64, 4, G, c};
        if (G == 256) {
            EpiFinal E{P.out, (const bf16_t*)(ws + WS_Y), (const float*)(ws + WS_MOD), P.g_post2, (float*)(ws + WS_XBUF), (unsigned*)(ws + WS_XCNT), (unsigned*)(ws + WS_BAR) + XB_TMO};
            gemm_phase<DFF, SchedPlain<DFF>, EpiFinal>(lds, S, E);
        } else { EpiBf16Plain E{(bf16_t*)(ws + WS_FF2OUT)};
            gemm_phase<DFF, SchedPlain<DFF>, EpiBf16Plain>(lds, S, E); SEAM(10); } }
    if (IN(11) && G != 256) { phase11(P); }
#undef IN
#undef SEAM
}

extern "C" void kernel_launch(void* const* d_in, const int* in_sizes, int n_in, void* d_out, int out_size, void* d_ws, size_t ws_size, hipStream_t stream) {
    static int grid_blocks = 0;
    if (grid_blocks == 0) {
        int dev = 0, cus = 0, per_cu = 0;
        hipGetDevice(&dev);
        hipDeviceGetAttribute(&cus, hipDeviceAttributeMultiprocessorCount, dev);
        if (hipFuncSetAttribute((const void*)fwd_megakernel, hipFuncAttributeMaxDynamicSharedMemorySize, LDS_BYTES) != hipSuccess) { fprintf(stderr, "hipFuncSetAttribute failed\n"); }
        if (hipOccupancyMaxActiveBlocksPerMultiprocessor(&per_cu, (const void*)fwd_megakernel, NTHREADS, LDS_BYTES) != hipSuccess || per_cu < 1) { fprintf(stderr, "occupancy query: %d\n", per_cu); per_cu = 1; }
        (void)hipGetLastError();
        grid_blocks = cus * 1;
        if (grid_blocks <= 0) grid_blocks = 256;
        if (n_in != 23 || ws_size < WS_END) fprintf(stderr, "kernel_launch: unexpected n_in %d / ws %zu\n", n_in, ws_size);
    }
    Params p{};
    const float** pp = (const float**)&p;
    for (int i = 0; i < 23; ++i) pp[i] = (const float*)d_in[i];
    p.out = (float*)d_out; p.ws = (unsigned char*)d_ws;
#if MK_MULTI_LAUNCH
    for (int k = 0; k < 12; ++k) { p.ph_lo = k; p.ph_hi = k + 1; hipLaunchKernelGGL(fwd_megakernel, dim3(grid_blocks), dim3(NTHREADS), LDS_BYTES, stream, p); }
#else
    p.ph_lo = 0; p.ph_hi = 12;
    (void)hipMemsetAsync((unsigned char*)d_ws + WS_BAR, 0, CTL_ZERO_BYTES, stream);
    void* args[] = {&p};
    hipError_t e = hipLaunchCooperativeKernel((const void*)fwd_megakernel, dim3(grid_blocks), dim3(NTHREADS), args, LDS_BYTES, stream);
    if (e != hipSuccess) fprintf(stderr, "cooperative launch failed: %s (grid %d)\n", hipGetErrorString(e), grid_blocks);
#endif
}
```

```cpp
#include <hip/hip_runtime.h>
#include <hip/hip_cooperative_groups.h>
#include <cstdio>
#include <cstdint>
namespace cg = cooperative_groups;

#define LAS __attribute__((address_space(3)))
typedef unsigned short bf16_t;
typedef short bf16x8 __attribute__((ext_vector_type(8)));
typedef float f32x4 __attribute__((ext_vector_type(4)));
typedef float f32x2 __attribute__((ext_vector_type(2)));
typedef unsigned u32x4 __attribute__((ext_vector_type(4)));
typedef unsigned u32x2 __attribute__((ext_vector_type(2)));

#ifndef MK_MULTI_LAUNCH
#define MK_MULTI_LAUNCH 0
#endif

constexpr int D = 1024, NB = 8, SEQ = 2048, MTOK = NB * SEQ, CTXL = 256, MCTX = NB * CTXL;
constexpr int CONVD = 512, CK = 31, NH = 4, DK = 64, DV = 128, DFF = 4096, NMOD = 6;
constexpr int COLEND = 4640;
constexpr int NPROJ = 19 * 256;
constexpr int NCH = 36;
constexpr float EPS = 1e-6f;
constexpr int NTHREADS = 512, NWAVES = 8;
constexpr int LDS_BYTES = 160 * 1024;

constexpr size_t WS_WIN = 0;
constexpr size_t WS_WFF1 = WS_WIN + (size_t)NPROJ * D * 2;
constexpr size_t WS_WFF2 = WS_WFF1 + (size_t)DFF * D * 2;
constexpr size_t WS_WOUT = WS_WFF2 + (size_t)D * DFF * 2;
constexpr size_t WS_WCONV = WS_WOUT + (size_t)D * D * 2;
constexpr size_t WS_WGLA = WS_WCONV + (size_t)D * CONVD * 2;
constexpr size_t WS_MOD = WS_WGLA + (size_t)D * 512 * 2;
constexpr size_t WS_CMOD = WS_MOD + (size_t)NB * NMOD * D * 4;
constexpr size_t WS_UC = WS_CMOD + (size_t)2 * D * 4;
constexpr size_t WS_KC = WS_UC + (size_t)MCTX * D * 2;
constexpr size_t WS_VC = WS_KC + (size_t)MCTX * 256 * 2;
constexpr size_t WS_DECC = WS_VC + (size_t)MCTX * 512 * 2;
constexpr size_t WS_DVEC = WS_DECC + (size_t)MCTX * 32 * 4;
constexpr size_t WS_U = WS_DVEC + (size_t)2 * NB * NH * NCH * 64 * 4;
constexpr size_t WS_G = WS_U + (size_t)MTOK * D * 2;
constexpr size_t WS_P = WS_G + (size_t)2 * NB * NH * NCH * 8192 * 2;
constexpr size_t WS_AGLU = WS_P;
constexpr size_t WS_Q = WS_AGLU + (size_t)MTOK * 512 * 2;
constexpr size_t WS_K = WS_Q + (size_t)MTOK * 256 * 2;
constexpr size_t WS_V = WS_K + (size_t)MTOK * 256 * 2;
constexpr size_t WS_R = WS_V + (size_t)MTOK * 512 * 2;
constexpr size_t WS_GATE = WS_R + (size_t)MTOK * 512 * 2;
constexpr size_t WS_DEC = WS_GATE + (size_t)MTOK * 2048 * 2;
constexpr size_t WS_END = WS_DEC + (size_t)MTOK * 32 * 4;
constexpr size_t WS_MERGED = WS_Q;
constexpr size_t WS_FFACT = WS_P;
constexpr size_t WS_FF2OUT = WS_U;
constexpr size_t WS_Y = WS_G;
constexpr size_t WS_BAR = WS_END;
constexpr int XCD_BAR_WORDS = 3456;
constexpr size_t WS_XCNT = WS_BAR + 16384;
constexpr size_t WS_XBUF = WS_XCNT + 3 * 16384;
constexpr size_t CTL_ZERO_BYTES = 16384 + 3 * 16384;
static_assert(WS_XBUF + 3 * (size_t)MTOK * 16 <= (size_t)256 * 1024 * 1024, "workspace (exchange)");
static_assert(WS_BAR + XCD_BAR_WORDS * 4 <= (size_t)256 * 1024 * 1024, "workspace");
static_assert((size_t)MTOK * DFF * 2 <= WS_END - WS_P, "ffact overlay");
static_assert((size_t)MTOK * D * 4 <= WS_P - WS_U, "ff2out overlay");
static_assert(WS_V + (size_t)MTOK * 512 * 2 - WS_Q == (size_t)MTOK * D * 2, "merged overlay");

struct Params {
    const float *x, *c, *ctx, *c_ctx, *w_mod, *b_mod, *g_pre1, *g_post1, *g_pre2, *g_post2, *w_in, *conv_w, *conv_b, *conv_ln_g, *conv_ln_b,
        *w_conv_out, *w_decay, *b_decay, *gla_norm_g, *w_gla_out, *w_out, *w_ff1, *w_ff2;
    float* out; unsigned char* ws;
    int ph_lo, ph_hi;
};

typedef __bf16 bf16x2_t __attribute__((ext_vector_type(2)));
typedef _Float16 h2_t __attribute__((ext_vector_type(2)));
__device__ __forceinline__ h2_t as_h2(unsigned u) { return __builtin_bit_cast(h2_t, u); }
__device__ __forceinline__ unsigned cvt_pk_f16(float lo, float hi) { h2_t v; v.x = (_Float16)lo; v.y = (_Float16)hi; return __builtin_bit_cast(unsigned, v); }
__device__ __forceinline__ unsigned cvt_pk_bf16(float lo, float hi) { bf16x2_t v; v.x = (__bf16)lo; v.y = (__bf16)hi; return __builtin_bit_cast(unsigned, v); }
__device__ __forceinline__ bf16_t f2bf(float x) { return __builtin_bit_cast(bf16_t, (__bf16)x); }
__device__ __forceinline__ float bf2f(unsigned h) { return __uint_as_float(h << 16); }
__device__ __forceinline__ float bflo(unsigned w) { return __uint_as_float(w << 16); }
__device__ __forceinline__ float bfhi(unsigned w) { return __uint_as_float(w & 0xffff0000u); }
__device__ __forceinline__ void unpack8(const u32x4 a, float (&f)[8]) {
    f[0] = bflo(a.x); f[1] = bfhi(a.x); f[2] = bflo(a.y); f[3] = bfhi(a.y); f[4] = bflo(a.z); f[5] = bfhi(a.z); f[6] = bflo(a.w); f[7] = bfhi(a.w);
}
__device__ __forceinline__ float wave_sum(float v) {
#pragma unroll
    for (int o = 1; o < 64; o <<= 1) v += __shfl_xor(v, o);
    return v;
}
__device__ __forceinline__ float sigmoidf_(float x) { return __builtin_amdgcn_rcpf(1.0f + __expf(-x)); }
__device__ __forceinline__ float siluf_(float x) { return x * sigmoidf_(x); }

#define XB_SPIN_CAP (1u << 18)
__device__ __forceinline__ unsigned xb_ld(unsigned* p)              { return __hip_atomic_load(p, __ATOMIC_RELAXED, __HIP_MEMORY_SCOPE_AGENT); }
constexpr int BM = 256, BK = 64, HALF = 128, HTB = HALF * BK * 2, NXCD = 8, WGM = 4;
__device__ __forceinline__ int lds_byte(int r, int c) { const int st = (r >> 4) * 2 + (c >> 5), rr = r & 15, cc = c & 31, ob = rr * 64 + cc * 2; return st * 1024 + (ob ^ (((ob >> 9) & 1) << 5)); }
__device__ __forceinline__ void stage_rc(int b, int& R, int& C) { const int st = b / 1024, sb = b % 1024, swz = sb ^ (((sb >> 9) & 1) << 5); R = (st >> 1) * 16 + swz / 64; C = (st & 1) * 32 + (swz % 64) / 2; }
__device__ __forceinline__ int perm32(int rho) { const int n = rho >> 4, i = rho & 15; return 8 * (i >> 2) + 4 * n + (i & 3); }

struct Unit { const char* A; const char* B; int pm, pn, kind; };

__device__ __forceinline__ void tile_remap(int L, int nM, int nN, int& pm, int& pn) {
    const int nwg = nM * nN; int wgid = L;
    { const int q = nwg / NXCD, r = nwg % NXCD, xcd = wgid % NXCD, off = wgid / NXCD; wgid = (xcd < r ? xcd * (q + 1) : r * (q + 1) + (xcd - r) * q) + off; }
    const int nig = WGM * nN, gid = wgid / nig, fm = gid * WGM, gsz = (nM - fm) < WGM ? (nM - fm) : WGM;
    pm = fm + ((wgid % nig) % gsz); pn = (wgid % nig) / gsz;
    pn = (pn + ((L % NXCD) * nN) / NXCD) % nN;
}

template <int K, class Sched, class Epi>
__device__ __forceinline__ void gemm_phase(LAS unsigned char* lds, const Sched& S, const Epi& E) {
    const int tid = threadIdx.x, wid = __builtin_amdgcn_readfirstlane(tid >> 6), lane = tid & 63, wr = wid >> 2, wc = wid & 3, fr = lane & 15, fq = lane >> 4;
    constexpr int nt = K / BK;
    unsigned voffA[2], voffB[2];
#pragma unroll
    for (int i = 0; i < 2; ++i) { int R, C; stage_rc(tid * 16 + i * 8192, R, C); const int Rb = (R & ~31) + perm32(R & 31);
        voffA[i] = (unsigned)(R * K + C) * 2u; voffB[i] = (unsigned)(Rb * K + C) * 2u; }
    constexpr size_t kstep = (size_t)(BK * 2);
    constexpr size_t hstep = (size_t)HALF * K * 2;
    const unsigned ldsw = (unsigned)wid * 1024u;
    const int aoff = lds_byte(wr * 64 + fr, fq * 8), boff = lds_byte(wc * 32 + fr, fq * 8);
#define PG8_SA(b, h) (((b) * 2 + (h)) * HTB)
#define PG8_SB(b, h) ((4 + (b) * 2 + (h)) * HTB)
#define PG8_STAGE(bufoff, gbase, voff) do { _Pragma("unroll") for (int _i = 0; _i < 2; ++_i) \
        __builtin_amdgcn_global_load_lds((const unsigned*)((const char*)(gbase) + (voff)[_i]), (LAS unsigned*)(lds + (bufoff) + ldsw + _i * 8192), 16, 0, 0); } while (0)
#define PG8_LDA(dst, b, h) do { _Pragma("unroll") for (int m = 0; m < 4; ++m) _Pragma("unroll") for (int k = 0; k < 2; ++k) dst[m][k] = *(const LAS bf16x8*)(lds + PG8_SA(b, h) + aoff + m * 2048 + k * 1024); } while (0)
#define PG8_LDB(dst, b, h) do { _Pragma("unroll") for (int n = 0; n < 2; ++n) _Pragma("unroll") for (int k = 0; k < 2; ++k) dst[n][k] = *(const LAS bf16x8*)(lds + PG8_SB(b, h) + boff + n * 2048 + k * 1024); } while (0)
#define PG8_MMA(ai, bj, At, Bt) do { __builtin_amdgcn_s_setprio(1); _Pragma("unroll") for (int m = 0; m < 4; ++m) _Pragma("unroll") for (int n = 0; n < 2; ++n) _Pragma("unroll") for (int k = 0; k < 2; ++k) \
        acc[ai][bj][m][n] = __builtin_amdgcn_mfma_f32_16x16x32_bf16(Bt[n][k], At[m][k], acc[ai][bj][m][n], 0, 0, 0); __builtin_amdgcn_s_setprio(0); } while (0)
#define PG8_WAIT_V(n) asm volatile("s_waitcnt vmcnt(" #n ")" ::: "memory")
#define PG8_WAIT_L(n) asm volatile("s_waitcnt lgkmcnt(" #n ")" ::: "memory")
#define PG8_BAR __builtin_amdgcn_s_barrier()
#define PG8_SCHED __builtin_amdgcn_sched_barrier(0)
    Unit cur, nxt; int ui = 0;
    if (!S.next(0, cur)) return;
    f32x4 acc[2][2][4][2];
#pragma unroll
    for (int a = 0; a < 2; ++a)
#pragma unroll
        for (int b = 0; b < 2; ++b)
#pragma unroll
            for (int m = 0; m < 4; ++m)
#pragma unroll
                for (int n = 0; n < 2; ++n) acc[a][b][m][n] = (f32x4){0.f, 0.f, 0.f, 0.f};
    bf16x8 At[4][2], B0[2][2], B1[2][2];
    const char* cA = cur.A; const char* cB = cur.B;
    const int krot = (nt >= 16) ? 2 * (int)(blockIdx.x % NXCD) : 0;
#define KOFF(t) ((size_t)(((t) + krot) & (nt - 1)) * kstep)
    PG8_STAGE(PG8_SB(0, 0), cB + KOFF(0), voffB); PG8_STAGE(PG8_SB(0, 1), cB + hstep + KOFF(0), voffB); PG8_STAGE(PG8_SA(0, 0), cA + KOFF(0), voffA); PG8_STAGE(PG8_SA(0, 1), cA + hstep + KOFF(0), voffA);
    if (wr == 1) PG8_BAR;
    PG8_WAIT_V(2); PG8_BAR;
    PG8_STAGE(PG8_SB(1, 0), cB + KOFF(1), voffB); PG8_STAGE(PG8_SA(1, 0), cA + KOFF(1), voffA); PG8_STAGE(PG8_SB(1, 1), cB + hstep + KOFF(1), voffB);
    PG8_WAIT_V(6); PG8_BAR;
    for (;;) {
        const bool has_next = S.next(ui + 1, nxt);
        const char* nA = has_next ? nxt.A : cA; const char* nB = has_next ? nxt.B : cB;
        for (int t = 0; t < nt; t += 2) {
            const bool last = (t == nt - 2);
            const char* a1 = cA + KOFF(t + 1);
            const char* a2 = last ? nA + KOFF(0) : cA + KOFF(t + 2); const char* b2 = last ? nB + KOFF(0) : cB + KOFF(t + 2);
            const char* a3 = last ? nA + KOFF(1) : cA + KOFF(t + 3); const char* b3 = last ? nB + KOFF(1) : cB + KOFF(t + 3);
            PG8_LDB(B0, 0, 0); PG8_LDB(B1, 0, 1); PG8_SCHED; PG8_LDA(At, 0, 0); PG8_STAGE(PG8_SA(1, 1), a1 + hstep, voffA);
            PG8_WAIT_V(8); PG8_WAIT_L(0); PG8_BAR; PG8_MMA(0, 0, At, B0); PG8_MMA(0, 1, At, B1); PG8_BAR; PG8_SCHED;
            PG8_LDA(At, 0, 1); PG8_STAGE(PG8_SB(0, 0), b2, voffB); PG8_STAGE(PG8_SB(0, 1), b2 + hstep, voffB); PG8_STAGE(PG8_SA(0, 0), a2, voffA);
            PG8_WAIT_V(8); PG8_WAIT_L(0); PG8_BAR; PG8_MMA(1, 0, At, B0); PG8_MMA(1, 1, At, B1); PG8_BAR; PG8_SCHED;
            PG8_LDB(B0, 1, 0); PG8_LDB(B1, 1, 1); PG8_SCHED; PG8_LDA(At, 1, 0); PG8_STAGE(PG8_SA(0, 1), a2 + hstep, voffA);
            PG8_WAIT_V(8); PG8_WAIT_L(0); PG8_BAR; PG8_MMA(0, 0, At, B0); PG8_MMA(0, 1, At, B1); PG8_BAR; PG8_SCHED;
            PG8_LDA(At, 1, 1); PG8_STAGE(PG8_SB(1, 0), b3, voffB); PG8_STAGE(PG8_SB(1, 1), b3 + hstep, voffB); PG8_STAGE(PG8_SA(1, 0), a3, voffA);
            PG8_WAIT_V(8); PG8_WAIT_L(0); PG8_BAR; PG8_MMA(1, 0, At, B0); PG8_MMA(1, 1, At, B1); PG8_BAR; PG8_SCHED;
        }
        if (wr == 0) PG8_BAR;
        bool keep = false;
        if constexpr (Epi::CHAIN) keep = E.chain(acc, cur, wr, wc, fr, fq);
        else if constexpr (!Epi::AFTER_DRAIN) E(acc, cur, wr, wc, fr, fq);
        if (!has_next) break;
        if (!keep) {
#pragma unroll
        for (int a = 0; a < 2; ++a)
#pragma unroll
            for (int b = 0; b < 2; ++b)
#pragma unroll
                for (int m = 0; m < 4; ++m)
#pragma unroll
                    for (int n = 0; n < 2; ++n) acc[a][b][m][n] = (f32x4){0.f, 0.f, 0.f, 0.f};
        }
        cur = nxt; cA = nA; cB = nB; ++ui;
        if (wr == 1) PG8_BAR;
    }
    PG8_WAIT_V(0);
    PG8_BAR;
    if constexpr (Epi::AFTER_DRAIN) E.fused(acc, cur, wr, wc, fr, fq, lds);
#undef KOFF
#undef PG8_SA
#undef PG8_SB
#undef PG8_STAGE
#undef PG8_LDA
#undef PG8_LDB
#undef PG8_MMA
#undef PG8_WAIT_V
#undef PG8_WAIT_L
#undef PG8_BAR
#undef PG8_SCHED
}

template <int ACT> __device__ __forceinline__ float actf(float v) {
    if (ACT == 1) return v * 0.125f;
    if (ACT == 2) return siluf_(v);
    if (ACT == 3) return sigmoidf_(v);
    if (ACT == 4) { const float r = fmaxf(v, 0.f); return r * r; }
    return v;
}
template <int ACT>
__device__ __forceinline__ void epi_store_bf16(const f32x4 (&acc)[2][2][4][2], bf16_t* dst, int ld, int row0, int col0) {
#pragma unroll
    for (int ai = 0; ai < 2; ++ai)
#pragma unroll
        for (int m = 0; m < 4; ++m) { bf16_t* rowp = dst + (size_t)(row0 + ai * HALF + m * 16) * ld + col0;
#pragma unroll
            for (int bj = 0; bj < 2; ++bj) { const f32x4 v0 = acc[ai][bj][m][0], v1 = acc[ai][bj][m][1];
                u32x4 w; w.x = cvt_pk_bf16(actf<ACT>(v0[0]), actf<ACT>(v0[1])); w.y = cvt_pk_bf16(actf<ACT>(v0[2]), actf<ACT>(v0[3]));
                w.z = cvt_pk_bf16(actf<ACT>(v1[0]), actf<ACT>(v1[1])); w.w = cvt_pk_bf16(actf<ACT>(v1[2]), actf<ACT>(v1[3]));
                *(u32x4*)(rowp + bj * HALF) = w; } }
}
__device__ __forceinline__ void epi_store_f32(const f32x4 (&acc)[2][2][4][2], float* dst, int ld, int row0, int col0) {
#pragma unroll
    for (int ai = 0; ai < 2; ++ai)
#pragma unroll
        for (int m = 0; m < 4; ++m) { float* rowp = dst + (size_t)(row0 + ai * HALF + m * 16) * ld + col0;
#pragma unroll
            for (int bj = 0; bj < 2; ++bj) { *(f32x4*)(rowp + bj * HALF) = acc[ai][bj][m][0]; *(f32x4*)(rowp + bj * HALF + 4) = acc[ai][bj][m][1]; } }
}

struct SchedProj {
    const char* U; const char* UC; const char* W; int G, c;
    __device__ __forceinline__ bool next(int i, Unit& u) const {
        const int L = i * G + c;
        constexpr size_t tstep = (size_t)BM * D * 2;
        if (L < 64 * 19) { int pm, pn; tile_remap(L, 64, 19, pm, pn); u.pm = pm; u.pn = pn; u.A = U + (size_t)pm * tstep; u.B = W + (size_t)pn * tstep; u.kind = 0; return true; }
        if (L < 64 * 19 + 32) { const int j = L - 64 * 19, pm = j & 7, q = j >> 3; const int pn = (q == 0) ? 5 : (q == 1) ? 6 : (q == 2) ? 7 : 18;
            u.pm = pm; u.pn = pn; u.A = UC + (size_t)pm * tstep; u.B = W + (size_t)pn * tstep; u.kind = 1; return true; }
        return false;
    }
};
struct EpiProj {
    static constexpr bool AFTER_DRAIN = false, CHAIN = false;
    unsigned char* ws;
    __device__ __forceinline__ void operator()(const f32x4 (&acc)[2][2][4][2], const Unit& u, int wr, int wc, int fr, int fq) const {
        const int row0 = u.pm * BM + wr * 64 + fr, cw = wc * 32 + 8 * fq, pn = u.pn;
        if (u.kind == 0) {
            if (pn < 4) {
                bf16_t* dst = (bf16_t*)(ws + WS_AGLU);
#pragma unroll
                for (int ai = 0; ai < 2; ++ai)
#pragma unroll
                    for (int m = 0; m < 4; ++m) { const f32x4 a0 = acc[ai][0][m][0], a1 = acc[ai][0][m][1], g0 = acc[ai][1][m][0], g1 = acc[ai][1][m][1];
                        u32x4 w; w.x = cvt_pk_f16(a0[0] * sigmoidf_(g0[0]), a0[1] * sigmoidf_(g0[1])); w.y = cvt_pk_f16(a0[2] * sigmoidf_(g0[2]), a0[3] * sigmoidf_(g0[3]));
                        w.z = cvt_pk_f16(a1[0] * sigmoidf_(g1[0]), a1[1] * sigmoidf_(g1[1])); w.w = cvt_pk_f16(a1[2] * sigmoidf_(g1[2]), a1[3] * sigmoidf_(g1[3]));
                        *(u32x4*)(dst + (size_t)(row0 + ai * HALF + m * 16) * 512 + pn * 128 + cw) = w; }
            } else if (pn == 4) epi_store_bf16<1>(acc, (bf16_t*)(ws + WS_Q), 256, row0, cw);
            else if (pn == 5) epi_store_bf16<0>(acc, (bf16_t*)(ws + WS_K), 256, row0, cw);
            else if (pn < 8) epi_store_bf16<0>(acc, (bf16_t*)(ws + WS_V), 512, row0, (pn - 6) * 256 + cw);
            else if (pn < 10) epi_store_bf16<2>(acc, (bf16_t*)(ws + WS_R), 512, row0, (pn - 8) * 256 + cw);
            else if (pn < 18) epi_store_bf16<3>(acc, (bf16_t*)(ws + WS_GATE), 2048, row0, (pn - 10) * 256 + cw);
            else { if (wc == 0) { float* dst = (float*)(ws + WS_DEC);
#pragma unroll
                    for (int ai = 0; ai < 2; ++ai)
#pragma unroll
                        for (int m = 0; m < 4; ++m) { float* rp = dst + (size_t)(row0 + ai * HALF + m * 16) * 32 + 8 * fq; *(f32x4*)rp = acc[ai][0][m][0]; *(f32x4*)(rp + 4) = acc[ai][0][m][1]; } } }
        } else {
            if (pn == 5) epi_store_bf16<0>(acc, (bf16_t*)(ws + WS_KC), 256, row0, cw);
            else if (pn < 8) epi_store_bf16<0>(acc, (bf16_t*)(ws + WS_VC), 512, row0, (pn - 6) * 256 + cw);
            else { if (wc == 0) { float* dst = (float*)(ws + WS_DECC);
#pragma unroll
                    for (int ai = 0; ai < 2; ++ai)
#pragma unroll
                        for (int m = 0; m < 4; ++m) { float* rp = dst + (size_t)(row0 + ai * HALF + m * 16) * 32 + 8 * fq; *(f32x4*)rp = acc[ai][0][m][0]; *(f32x4*)(rp + 4) = acc[ai][0][m][1]; } } }
        }
    }
};

__device__ __forceinline__ void panel_rowstat(const f32x4 (&v)[2][2][4][2], const Unit& u, int wr, int wc, int fr, int fq, LAS unsigned char* lds, float* xbuf, unsigned* cnt, unsigned* tmo) {
    const int tid = threadIdx.x;
    LAS float* Pt = (LAS float*)lds;
    LAS float* RS = (LAS float*)(lds + 4096);
#pragma unroll
    for (int ai = 0; ai < 2; ++ai)
#pragma unroll
        for (int m = 0; m < 4; ++m) { float s = 0.f;
#pragma unroll
            for (int bj = 0; bj < 2; ++bj)
#pragma unroll
                for (int n = 0; n < 2; ++n) { const f32x4 x = v[ai][bj][m][n]; s += (x[0] * x[0] + x[1] * x[1]) + (x[2] * x[2] + x[3] * x[3]); }
            s += __shfl_xor(s, 16); s += __shfl_xor(s, 32);
            if (fq == 0) Pt[(ai * HALF + wr * 64 + m * 16 + fr) * 4 + wc] = s; }
    __syncthreads();
    if (tid < 256) { const f32x4 p = *(const LAS f32x4*)(Pt + tid * 4);
        __hip_atomic_store(xbuf + ((size_t)u.pm * 256 + tid) * 4 + u.pn, (p[0] + p[1]) + (p[2] + p[3]), __ATOMIC_RELAXED, __HIP_MEMORY_SCOPE_AGENT); }
    asm volatile("s_waitcnt vmcnt(0)" ::: "memory");
    __syncthreads();
    if (tid == 0) { unsigned* cw_ = cnt + 64 * u.pm;
        (void)__hip_atomic_fetch_add(cw_, 1u, __ATOMIC_RELAXED, __HIP_MEMORY_SCOPE_AGENT);
        unsigned sp = 0;
        while (__hip_atomic_load(cw_, __ATOMIC_RELAXED, __HIP_MEMORY_SCOPE_AGENT) < 4u) { __builtin_amdgcn_s_sleep(1);
            if ((++sp & 255u) == 0u) { if (xb_ld(tmo)) break; if (sp > XB_SPIN_CAP) { atomicAdd(tmo, 1u); break; } } }
        __builtin_amdgcn_fence(__ATOMIC_ACQUIRE, "agent");
        asm volatile("s_waitcnt vmcnt(0)" ::: "memory"); }
    __syncthreads();
    if (tid < 256) { const float* xp = xbuf + ((size_t)u.pm * 256 + tid) * 4; float t = 0.f;
#pragma unroll
        for (int q = 0; q < 4; ++q) t += __hip_atomic_load(xp + q, __ATOMIC_RELAXED, __HIP_MEMORY_SCOPE_AGENT);
        RS[tid] = rsqrtf(t * (1.0f / D) + EPS); }
    __syncthreads();
}
struct EpiFinal {
    static constexpr bool AFTER_DRAIN = true, CHAIN = false;
    float* out; const bf16_t* hb; const float* mod; const float* g_post2; float* xbuf; unsigned* cnt; unsigned* tmo;
    __device__ __forceinline__ void operator()(const f32x4 (&)[2][2][4][2], const Unit&, int, int, int, int) const {}
    __device__ __forceinline__ void fused(const f32x4 (&acc)[2][2][4][2], const Unit& u, int wr, int wc, int fr, int fq, LAS unsigned char* lds) const {
        panel_rowstat(acc, u, wr, wc, fr, fq, lds, xbuf, cnt, tmo);
        const LAS float* RS = (const LAS float*)(lds + 4096);
        const int rl0 = wr * 64 + fr, col0 = u.pn * BM + wc * 32 + 8 * fq;
        const float* md = mod + (size_t)(u.pm >> 3) * (NMOD * D) + 5 * D;
        f32x4 ga[2][2];
#pragma unroll
        for (int bj = 0; bj < 2; ++bj)
#pragma unroll
            for (int n = 0; n < 2; ++n) ga[bj][n] = *(const f32x4*)(md + col0 + bj * HALF + 4 * n) * *(const f32x4*)(g_post2 + col0 + bj * HALF + 4 * n);
#pragma unroll
        for (int ai = 0; ai < 2; ++ai)
#pragma unroll
            for (int m = 0; m < 4; ++m) { const int rl = rl0 + ai * HALF + m * 16; const float rs = RS[rl];
                const size_t off = ((size_t)u.pm * BM + rl) * D + col0;
#pragma unroll
                for (int bj = 0; bj < 2; ++bj) { const u32x4 raw = __builtin_nontemporal_load((const u32x4*)(hb + off + bj * HALF));
                    const f32x4 h0 = (f32x4){bflo(raw.x), bfhi(raw.x), bflo(raw.y), bfhi(raw.y)}, h1 = (f32x4){bflo(raw.z), bfhi(raw.z), bflo(raw.w), bfhi(raw.w)};
                    __builtin_nontemporal_store(h0 + ga[bj][0] * (acc[ai][bj][m][0] * rs), (f32x4*)(out + off + bj * HALF)); __builtin_nontemporal_store(h1 + ga[bj][1] * (acc[ai][bj][m][1] * rs), (f32x4*)(out + off + bj * HALF + 4)); } }
    }
};

struct EpiMid {
    static constexpr bool AFTER_DRAIN = true, CHAIN = false;
    const float* x; bf16_t* hb; bf16_t* u2; const float* mod; const float* g_post1; const float* g_pre2; float* xbuf; unsigned* cnt; unsigned* tmo;
    __device__ __forceinline__ void operator()(const f32x4 (&)[2][2][4][2], const Unit&, int, int, int, int) const {}
    __device__ __forceinline__ void fused(f32x4 (&acc)[2][2][4][2], const Unit& u, int wr, int wc, int fr, int fq, LAS unsigned char* lds) const {
        const LAS float* RS = (const LAS float*)(lds + 4096);
        const int rl0 = wr * 64 + fr, col0 = u.pn * BM + wc * 32 + 8 * fq;
        const float* md = mod + (size_t)(u.pm >> 3) * (NMOD * D);
        panel_rowstat(acc, u, wr, wc, fr, fq, lds, xbuf, cnt, tmo);
        {
            f32x4 ga[2][2];
#pragma unroll
            for (int bj = 0; bj < 2; ++bj)
#pragma unroll
                for (int n = 0; n < 2; ++n) ga[bj][n] = *(const f32x4*)(md + 2 * D + col0 + bj * HALF + 4 * n) * *(const f32x4*)(g_post1 + col0 + bj * HALF + 4 * n);
#pragma unroll
            for (int ai = 0; ai < 2; ++ai)
#pragma unroll
                for (int m = 0; m < 4; ++m) { const int rl = rl0 + ai * HALF + m * 16; const float rs = RS[rl];
                    const size_t off = ((size_t)u.pm * BM + rl) * D + col0;
#pragma unroll
                    for (int bj = 0; bj < 2; ++bj) { const f32x4 h0 = __builtin_nontemporal_load((const f32x4*)(x + off + bj * HALF)) + ga[bj][0] * (acc[ai][bj][m][0] * rs), h1 = __builtin_nontemporal_load((const f32x4*)(x + off + bj * HALF + 4)) + ga[bj][1] * (acc[ai][bj][m][1] * rs);
                        acc[ai][bj][m][0] = h0; acc[ai][bj][m][1] = h1;
                        u32x4 w; w.x = cvt_pk_bf16(h0[0], h0[1]); w.y = cvt_pk_bf16(h0[2], h0[3]); w.z = cvt_pk_bf16(h1[0], h1[1]); w.w = cvt_pk_bf16(h1[2], h1[3]);
                        *(u32x4*)(hb + off + bj * HALF) = w; } }
        }
        __syncthreads();
        panel_rowstat(acc, u, wr, wc, fr, fq, lds, xbuf + (size_t)MTOK * 4, cnt + 4096, tmo);
        {
            f32x4 gb[2][2], gc[2][2];
#pragma unroll
            for (int bj = 0; bj < 2; ++bj)
#pragma unroll
                for (int n = 0; n < 2; ++n) { const int col = col0 + bj * HALF + 4 * n;
                    gb[bj][n] = *(const f32x4*)(g_pre2 + col) * (1.0f + *(const f32x4*)(md + 4 * D + col)); gc[bj][n] = *(const f32x4*)(md + 3 * D + col); }
#pragma unroll
            for (int ai = 0; ai < 2; ++ai)
#pragma unroll
                for (int m = 0; m < 4; ++m) { const int rl = rl0 + ai * HALF + m * 16; const float rs = RS[rl];
                    bf16_t* up = u2 + ((size_t)u.pm * BM + rl) * D + col0;
#pragma unroll
                    for (int bj = 0; bj < 2; ++bj) { const f32x4 v0 = acc[ai][bj][m][0] * rs * gb[bj][0] + gc[bj][0], v1 = acc[ai][bj][m][1] * rs * gb[bj][1] + gc[bj][1];
                        u32x4 w; w.x = cvt_pk_bf16(v0[0], v0[1]); w.y = cvt_pk_bf16(v0[2], v0[3]); w.z = cvt_pk_bf16(v1[0], v1[1]); w.w = cvt_pk_bf16(v1[2], v1[3]);
                        *(u32x4*)(up + bj * HALF) = w; } }
        }
    }
};

template <int K> struct SchedPlain {
    const char* A; const char* W; int nM, nN, G, c;
    __device__ __forceinline__ bool next(int i, Unit& u) const {
        const int L = i * G + c; if (L >= nM * nN) return false;
        constexpr size_t tstep = (size_t)BM * K * 2;
        int pm, pn; tile_remap(L, nM, nN, pm, pn); u.pm = pm; u.pn = pn; u.A = A + (size_t)pm * tstep; u.B = W + (size_t)pn * tstep; u.kind = 0; return true;
    }
};
struct SchedMerge {
    const char* A1; const char* A2; const char* W1; const char* W2; int G, c;
    __device__ __forceinline__ bool next(int i, Unit& u) const {
        const int L = (i >> 1) * G + c, sub = i & 1; if (L >= 64 * 4) return false;
        constexpr size_t tstep = (size_t)BM * 512 * 2;
        int pm, pn; tile_remap(L, 64, 4, pm, pn); u.pm = pm; u.pn = pn; u.kind = sub;
        u.A = (sub ? A2 : A1) + (size_t)pm * tstep; u.B = (sub ? W2 : W1) + (size_t)pn * tstep; return true;
    }
};
struct EpiMerge {
    static constexpr bool AFTER_DRAIN = false, CHAIN = true;
    unsigned char* ws;
    __device__ __forceinline__ void operator()(const f32x4 (&)[2][2][4][2], const Unit&, int, int, int, int) const {}
    __device__ __forceinline__ bool chain(f32x4 (&acc)[2][2][4][2], const Unit& u, int wr, int wc, int fr, int fq) const {
        const int row0 = u.pm * BM + wr * 64 + fr, col0 = u.pn * BM + wc * 32 + 8 * fq;
        const bf16_t* gate = (const bf16_t*)(ws + WS_GATE);
        bf16_t* mg = (bf16_t*)(ws + WS_MERGED);
        if (u.kind == 0) {
#pragma unroll
            for (int ai = 0; ai < 2; ++ai)
#pragma unroll
                for (int m = 0; m < 4; ++m) { const size_t row = (size_t)(row0 + ai * HALF + m * 16);
#pragma unroll
                    for (int bj = 0; bj < 2; ++bj) { const int col = col0 + bj * HALF;
                        const u32x4 g1 = __builtin_nontemporal_load((const u32x4*)(gate + row * 2048 + col)), g2 = *(const u32x4*)(gate + row * 2048 + D + col);
                        float n1[8], n2[8]; unpack8(g1, n1); unpack8(g2, n2);
#pragma unroll
                        for (int e = 0; e < 4; ++e) { acc[ai][bj][m][0][e] *= n1[e] * __builtin_amdgcn_rcpf(fmaxf(n2[e], 1e-30f)); acc[ai][bj][m][1][e] *= n1[4 + e] * __builtin_amdgcn_rcpf(fmaxf(n2[4 + e], 1e-30f)); } } }
            return true;
        }
#pragma unroll
        for (int ai = 0; ai < 2; ++ai)
#pragma unroll
            for (int m = 0; m < 4; ++m) { const size_t row = (size_t)(row0 + ai * HALF + m * 16);
#pragma unroll
                for (int bj = 0; bj < 2; ++bj) { const int col = col0 + bj * HALF;
                    const u32x4 g = __builtin_nontemporal_load((const u32x4*)(gate + row * 2048 + D + col));
                    const f32x4 v0 = acc[ai][bj][m][0], v1 = acc[ai][bj][m][1];
                    u32x4 w; w.x = cvt_pk_bf16(v0[0] * bflo(g.x), v0[1] * bfhi(g.x)); w.y = cvt_pk_bf16(v0[2] * bflo(g.y), v0[3] * bfhi(g.y));
                    w.z = cvt_pk_bf16(v1[0] * bflo(g.z), v1[1] * bfhi(g.z)); w.w = cvt_pk_bf16(v1[2] * bflo(g.w), v1[3] * bfhi(g.w));
                    *(u32x4*)(mg + row * D + col) = w; } }
        return false;
    }
};
struct EpiF32 {
    static constexpr bool AFTER_DRAIN = false, CHAIN = false;
    float* dst;
    __device__ __forceinline__ void operator()(const f32x4 (&acc)[2][2][4][2], const Unit& u, int wr, int wc, int fr, int fq) const {
        epi_store_f32(acc, dst, D, u.pm * BM + wr * 64 + fr, u.pn * BM + wc * 32 + 8 * fq);
    }
};
struct EpiBf16Plain {
    static constexpr bool AFTER_DRAIN = false, CHAIN = false;
    bf16_t* dst;
    __device__ __forceinline__ void operator()(const f32x4 (&acc)[2][2][4][2], const Unit& u, int wr, int wc, int fr, int fq) const {
        epi_store_bf16<0>(acc, dst, D, u.pm * BM + wr * 64 + fr, u.pn * BM + wc * 32 + 8 * fq);
    }
};
struct EpiRelu2 {
    static constexpr bool AFTER_DRAIN = false, CHAIN = false;
    bf16_t* dst;
    __device__ __forceinline__ void operator()(const f32x4 (&acc)[2][2][4][2], const Unit& u, int wr, int wc, int fr, int fq) const {
        epi_store_bf16<4>(acc, dst, DFF, u.pm * BM + wr * 64 + fr, u.pn * BM + wc * 32 + 8 * fq);
    }
};

__device__ __forceinline__ int win_src_base(int g) {
    const int t = g >> 3, gi = g & 7;
    if (t < 4) return (gi < 4) ? (t * 128 + gi * 32) : (512 + t * 128 + (gi - 4) * 32);
    if (t == 4) return 1024 + gi * 32;
    if (t == 5) return 1280 + gi * 32;
    if (t < 8) return 1536 + (t - 6) * 256 + gi * 32;
    if (t < 10) return 2048 + (t - 8) * 256 + gi * 32;
    if (t < 18) return 2592 + (t - 10) * 256 + gi * 32;
    return gi == 0 ? 2560 : -1;
}
__device__ __forceinline__ void transpose_item(const float* W, int K, int N, int src0, bf16_t* WT, int dst0, int k0, LAS float* scr, int lane) {
    const int c = lane & 7;
    if (src0 < 0) {
#pragma unroll
        for (int j = 0; j < 4; ++j) { const int n = (lane >> 3) + 8 * j; *(u32x4*)(WT + (size_t)(dst0 + n) * K + k0 + 8 * c) = (u32x4){0u, 0u, 0u, 0u}; }
        return;
    }
    float tmp[32];
#pragma unroll
    for (int i = 0; i < 32; ++i) { const int kk = 2 * i + (lane >> 5); tmp[i] = __builtin_nontemporal_load(W + (size_t)(k0 + kk) * N + src0 + (lane & 31)); }
#pragma unroll
    for (int i = 0; i < 32; ++i) { const int kk = 2 * i + (lane >> 5); scr[kk * 33 + (lane & 31)] = tmp[i]; }
    asm volatile("s_waitcnt lgkmcnt(0)" ::: "memory");
#pragma unroll
    for (int j = 0; j < 4; ++j) { const int n = (lane >> 3) + 8 * j; const LAS float* s = scr + (8 * c) * 33 + n;
        u32x4 o; o.x = cvt_pk_bf16(s[0 * 33], s[1 * 33]); o.y = cvt_pk_bf16(s[2 * 33], s[3 * 33]); o.z = cvt_pk_bf16(s[4 * 33], s[5 * 33]); o.w = cvt_pk_bf16(s[6 * 33], s[7 * 33]);
        *(u32x4*)(WT + (size_t)(dst0 + n) * K + k0 + 8 * c) = o; }
    asm volatile("s_waitcnt lgkmcnt(0)" ::: "memory");
}

__device__ __forceinline__ void phase0(const Params& P, LAS unsigned char* lds) {
    const int tid = threadIdx.x, lane = tid & 63, wave = tid >> 6;
    unsigned char* ws = P.ws;
    if ((int)blockIdx.x < 192) {
        LAS float* sc = (LAS float*)(lds + 80 * 1024);
        LAS float* red = (LAS float*)(lds + 80 * 1024 + 9 * 1024 * 4);
        for (int i = tid; i < 9 * 1024; i += NTHREADS) { const float v = (i < 8 * 1024) ? P.c[i] : P.c_ctx[i - 8 * 1024]; sc[i] = siluf_(v); }
        __syncthreads();
        for (int item = blockIdx.x; item < 192; item += gridDim.x) {
            const int n0 = item * 32, kg = tid >> 5, j = tid & 31;
            float a[9];
#pragma unroll
            for (int b = 0; b < 9; ++b) a[b] = 0.f;
            const float* wp = P.w_mod + (size_t)(kg * 64) * (NMOD * D) + n0 + j;
#pragma unroll 16
            for (int k = 0; k < 64; ++k) { const float w = __builtin_nontemporal_load(wp + (size_t)k * (NMOD * D));
#pragma unroll
                for (int b = 0; b < 9; ++b) a[b] += sc[b * 1024 + kg * 64 + k] * w; }
#pragma unroll
            for (int b = 0; b < 9; ++b) red[(kg * 9 + b) * 32 + j] = a[b];
            __syncthreads();
            if (tid < 288) { const int b = tid >> 5, jj = tid & 31; float s = 0.f;
#pragma unroll
                for (int g = 0; g < 16; ++g) s += red[(g * 9 + b) * 32 + jj];
                s += P.b_mod[n0 + jj];
                if (b < 8) ((float*)(ws + WS_MOD))[b * (NMOD * D) + n0 + jj] = s;
                else if (n0 + jj < 2 * D) ((float*)(ws + WS_CMOD))[n0 + jj] = s; }
            __syncthreads();
        }
    }
    LAS float* scr = (LAS float*)(lds + wave * 8448);
    const int gw = blockIdx.x * NWAVES + wave, NGW = gridDim.x * NWAVES;
    constexpr int I_IN = 16 * 152, I_F1 = 16 * 128, I_F2 = 64 * 32, I_O = 16 * 32, I_C = 8 * 32, I_G = 8 * 32;
    constexpr int NITEMS = I_IN + I_F1 + I_F2 + I_O + I_C + I_G;
    for (int it = gw; it < NITEMS; it += NGW) {
        int r = it;
        if (r < I_IN) { const int kb = r / 152, g = r % 152; transpose_item(P.w_in, D, COLEND, win_src_base(g), (bf16_t*)(ws + WS_WIN), g * 32, kb * 64, scr, lane); continue; } r -= I_IN;
        if (r < I_F1) { const int kb = r / 128, g = r % 128; transpose_item(P.w_ff1, D, DFF, g * 32, (bf16_t*)(ws + WS_WFF1), g * 32, kb * 64, scr, lane); continue; } r -= I_F1;
        if (r < I_F2) { const int kb = r / 32, g = r % 32; transpose_item(P.w_ff2, DFF, D, g * 32, (bf16_t*)(ws + WS_WFF2), g * 32, kb * 64, scr, lane); continue; } r -= I_F2;
        if (r < I_O) { const int kb = r / 32, g = r % 32; transpose_item(P.w_out, D, D, g * 32, (bf16_t*)(ws + WS_WOUT), g * 32, kb * 64, scr, lane); continue; } r -= I_O;
        if (r < I_C) { const int kb = r / 32, g = r % 32; transpose_item(P.w_conv_out, CONVD, D, g * 32, (bf16_t*)(ws + WS_WCONV), g * 32, kb * 64, scr, lane); continue; } r -= I_C;
        { const int kb = r / 32, g = r % 32; transpose_item(P.w_gla_out, 512, D, g * 32, (bf16_t*)(ws + WS_WGLA), g * 32, kb * 64, scr, lane); }
    }
}

__device__ __forceinline__ void store_row_bf16(bf16_t* orow, int lane, const f32x4 (&v)[4]) {
    u32x2* o8 = (u32x2*)orow + lane;
#pragma unroll
    for (int j = 0; j < 4; ++j) { u32x2 w; w.x = cvt_pk_bf16(v[j][0], v[j][1]); w.y = cvt_pk_bf16(v[j][2], v[j][3]); o8[64 * j] = w; }
}
__device__ __forceinline__ float sumsq4(const f32x4 (&v)[4]) {
    float s = 0.f;
#pragma unroll
    for (int j = 0; j < 4; ++j) s += (v[j][0] * v[j][0] + v[j][1] * v[j][1]) + (v[j][2] * v[j][2] + v[j][3] * v[j][3]);
    return s;
}
__device__ __forceinline__ void load_row_bf16(const bf16_t* irow, int lane, f32x4 (&v)[4]) {
    const u32x2* i8 = (const u32x2*)irow + lane;
#pragma unroll
    for (int j = 0; j < 4; ++j) { const u32x2 w = i8[64 * j]; v[j] = (f32x4){bflo(w.x), bfhi(w.x), bflo(w.y), bfhi(w.y)}; }
}
__device__ __forceinline__ void phase1(const Params& P) {
    const int lane = threadIdx.x & 63, wave = threadIdx.x >> 6;
    const int gw = blockIdx.x * NWAVES + wave, NGW = gridDim.x * NWAVES;
    const float* MOD = (const float*)(P.ws + WS_MOD); const float* CMOD = (const float*)(P.ws + WS_CMOD);
    bf16_t* U = (bf16_t*)(P.ws + WS_U); bf16_t* UC = (bf16_t*)(P.ws + WS_UC);
    for (int ch = gw; ch < MTOK / 8 + MCTX / 8; ch += NGW) {
        const bool isctx = ch >= MTOK / 8;
        const int row0 = isctx ? (ch - MTOK / 8) * 8 : ch * 8;
        const float* mod = isctx ? CMOD : MOD + (size_t)(row0 / SEQ) * (NMOD * D);
        const float* src = isctx ? P.ctx : P.x; bf16_t* dst = isctx ? UC : U;
        f32x4 sc[4], sh[4];
#pragma unroll
        for (int j = 0; j < 4; ++j) { const int col = 4 * lane + 256 * j; const f32x4 g = *(const f32x4*)(P.g_pre1 + col), s = *(const f32x4*)(mod + D + col);
            sc[j] = g * (1.0f + s); sh[j] = *(const f32x4*)(mod + col); }
        for (int r = 0; r < 8; ++r) { const size_t row = (size_t)(row0 + r);
            const f32x4* xr = (const f32x4*)(src + row * D) + lane; f32x4 v[4];
#pragma unroll
            for (int j = 0; j < 4; ++j) v[j] = __builtin_nontemporal_load(xr + 64 * j);
            const float rs = rsqrtf(wave_sum(sumsq4(v)) * (1.0f / D) + EPS);
#pragma unroll
            for (int j = 0; j < 4; ++j) v[j] = v[j] * rs * sc[j] + sh[j];
            store_row_bf16(dst + row * D, lane, v); }
    }
}
__device__ __forceinline__ void phase8(const Params& P) {
    const int lane = threadIdx.x & 63, wave = threadIdx.x >> 6;
    const int gw = blockIdx.x * NWAVES + wave, NGW = gridDim.x * NWAVES;
    const float* MOD = (const float*)(P.ws + WS_MOD); bf16_t* U = (bf16_t*)(P.ws + WS_U);
    for (int ch = gw; ch < MTOK / 8; ch += NGW) {
        const int row0 = ch * 8; const float* mod = MOD + (size_t)(row0 / SEQ) * (NMOD * D);
        f32x4 ga[4], gb[4], gc[4];
#pragma unroll
        for (int j = 0; j < 4; ++j) { const int col = 4 * lane + 256 * j;
            ga[j] = *(const f32x4*)(mod + 2 * D + col) * *(const f32x4*)(P.g_post1 + col);
            gb[j] = *(const f32x4*)(P.g_pre2 + col) * (1.0f + *(const f32x4*)(mod + 4 * D + col));
            gc[j] = *(const f32x4*)(mod + 3 * D + col); }
        for (int r = 0; r < 8; ++r) { const size_t row = (size_t)(row0 + r);
            f32x4* yr = (f32x4*)(P.out + row * D) + lane; const f32x4* xr = (const f32x4*)(P.x + row * D) + lane; f32x4 y[4], h[4];
            load_row_bf16((const bf16_t*)(P.ws + WS_Y) + row * D, lane, y);
#pragma unroll
            for (int j = 0; j < 4; ++j) h[j] = xr[64 * j];
            const float rs = rsqrtf(wave_sum(sumsq4(y)) * (1.0f / D) + EPS);
#pragma unroll
            for (int j = 0; j < 4; ++j) { h[j] = h[j] + ga[j] * (y[j] * rs); yr[64 * j] = h[j]; }
            const float rs2 = rsqrtf(wave_sum(sumsq4(h)) * (1.0f / D) + EPS);
#pragma unroll
            for (int j = 0; j < 4; ++j) h[j] = h[j] * rs2 * gb[j] + gc[j];
            store_row_bf16(U + row * D, lane, h); }
    }
}
__device__ __forceinline__ void phase11(const Params& P) {
    const int lane = threadIdx.x & 63, wave = threadIdx.x >> 6;
    const int gw = blockIdx.x * NWAVES + wave, NGW = gridDim.x * NWAVES;
    const float* MOD = (const float*)(P.ws + WS_MOD); const bf16_t* FF = (const bf16_t*)(P.ws + WS_FF2OUT);
    for (int ch = gw; ch < MTOK / 8; ch += NGW) {
        const int row0 = ch * 8; const float* mod = MOD + (size_t)(row0 / SEQ) * (NMOD * D);
        f32x4 ga[4];
#pragma unroll
        for (int j = 0; j < 4; ++j) { const int col = 4 * lane + 256 * j; ga[j] = *(const f32x4*)(mod + 5 * D + col) * *(const f32x4*)(P.g_post2 + col); }
        for (int r = 0; r < 8; ++r) { const size_t row = (size_t)(row0 + r);
            f32x4* hr = (f32x4*)(P.out + row * D) + lane; f32x4 y[4], h[4];
            load_row_bf16(FF + row * D, lane, y);
#pragma unroll
            for (int j = 0; j < 4; ++j) h[j] = hr[64 * j];
            const float rs = rsqrtf(wave_sum(sumsq4(y)) * (1.0f / D) + EPS);
#pragma unroll
            for (int j = 0; j < 4; ++j) hr[64 * j] = h[j] + ga[j] * (y[j] * rs); }
    }
}

constexpr int CV_CW = 0, CV_AT = 31 * 512 * 4;
__device__ __forceinline__ void conv_unit(const Params& P, LAS unsigned char* lds, int b, int row) {
    const int tid = threadIdx.x;
    LAS bf16_t* at = (LAS bf16_t*)(lds + CV_AT);
    const bf16_t* AG = (const bf16_t*)(P.ws + WS_AGLU);
    bf16_t* A1 = (bf16_t*)(P.ws + WS_U);
    const size_t tok0 = (size_t)b * SEQ + (size_t)row * 64;
    LAS unsigned* cwh = (LAS unsigned*)(lds + CV_CW);
    for (int i = tid; i < CK * 256; i += NTHREADS) { const f32x2 w2 = *(const f32x2*)(P.conv_w + 2 * i); cwh[i] = cvt_pk_f16(w2.x, w2.y); }
    for (int i = tid; i < 2048; i += NTHREADS) { const int t = i >> 5, ch = (i & 31) * 8; *(LAS u32x4*)(at + (t + 15) * 256 + ch) = *(const u32x4*)(AG + (tok0 + t) * 512 + ch); }
    for (int i = tid; i < 30 * 32; i += NTHREADS) { const int t = i >> 5, ch = (i & 31) * 8; *(LAS u32x4*)(at + (t < 15 ? t : t + 64) * 256 + ch) = (u32x4){0u, 0u, 0u, 0u}; }
    __syncthreads();
    const int cgp = tid & 31, wq = tid >> 5;
    h2_t ah[4][4], av[4][4];
#pragma unroll
    for (int i = 0; i < 4; ++i)
#pragma unroll
        for (int p = 0; p < 4; ++p) { ah[i][p] = (h2_t){(_Float16)0.f, (_Float16)0.f}; av[i][p] = (h2_t){(_Float16)0.f, (_Float16)0.f}; }
#pragma unroll 2
    for (int k = 0; k < CK; ++k) {
        const u32x4 wr_ = *(const LAS u32x4*)(cwh + k * 256 + cgp * 4);
        const h2_t w0 = as_h2(wr_.x), w1 = as_h2(wr_.y), w2 = as_h2(wr_.z), w3 = as_h2(wr_.w);
#pragma unroll
        for (int i = 0; i < 4; ++i) { const u32x4 raw = *(const LAS u32x4*)(at + (wq + 16 * i + k) * 256 + cgp * 8);
            ah[i][0] += as_h2(raw.x) * w0; ah[i][1] += as_h2(raw.y) * w1;
            ah[i][2] += as_h2(raw.z) * w2; ah[i][3] += as_h2(raw.w) * w3; }
    }
    {
        const int r_lo = row - 15 < 0 ? 0 : row - 15, r_hi = row + 15 > 31 ? 31 : row + 15;
        const bf16_t* srcb = AG + ((size_t)b * SEQ + wq) * 512 + 256 + cgp * 8;
#pragma unroll 4
        for (int rr = r_lo; rr <= r_hi; ++rr) { const int k = rr - row + 15;
            const u32x4 wr_ = *(const LAS u32x4*)(cwh + k * 256 + 128 + cgp * 4);
            const h2_t w0 = as_h2(wr_.x), w1 = as_h2(wr_.y), w2 = as_h2(wr_.z), w3 = as_h2(wr_.w);
            const bf16_t* src = srcb + (size_t)rr * 64 * 512;
            u32x4 raw4[4];
#pragma unroll
            for (int i = 0; i < 4; ++i) raw4[i] = *(const u32x4*)(src + (size_t)(16 * i) * 512);
#pragma unroll
            for (int i = 0; i < 4; ++i) { const u32x4 raw = raw4[i];
                av[i][0] += as_h2(raw.x) * w0; av[i][1] += as_h2(raw.y) * w1;
                av[i][2] += as_h2(raw.z) * w2; av[i][3] += as_h2(raw.w) * w3; }
        }
    }
    float yh[4][8], yv[4][8];
    {
        const f32x4 b0 = *(const f32x4*)(P.conv_b + cgp * 8), b1 = *(const f32x4*)(P.conv_b + cgp * 8 + 4);
        const f32x4 c0 = *(const f32x4*)(P.conv_b + 256 + cgp * 8), c1 = *(const f32x4*)(P.conv_b + 256 + cgp * 8 + 4);
#pragma unroll
        for (int i = 0; i < 4; ++i)
#pragma unroll
            for (int p = 0; p < 4; ++p) { const float bh_lo = (p < 2) ? b0[2 * (p & 1)] : b1[2 * (p & 1)], bh_hi = (p < 2) ? b0[2 * (p & 1) + 1] : b1[2 * (p & 1) + 1];
                const float bv_lo = (p < 2) ? c0[2 * (p & 1)] : c1[2 * (p & 1)], bv_hi = (p < 2) ? c0[2 * (p & 1) + 1] : c1[2 * (p & 1) + 1];
                yh[i][2 * p] = (float)ah[i][p].x + bh_lo; yh[i][2 * p + 1] = (float)ah[i][p].y + bh_hi;
                yv[i][2 * p] = (float)av[i][p].x + bv_lo; yv[i][2 * p + 1] = (float)av[i][p].y + bv_hi; }
    }
    const f32x4 gh0 = *(const f32x4*)(P.conv_ln_g + cgp * 8), gh1 = *(const f32x4*)(P.conv_ln_g + cgp * 8 + 4), bh0 = *(const f32x4*)(P.conv_ln_b + cgp * 8), bh1 = *(const f32x4*)(P.conv_ln_b + cgp * 8 + 4);
    const f32x4 gv0 = *(const f32x4*)(P.conv_ln_g + 256 + cgp * 8), gv1 = *(const f32x4*)(P.conv_ln_g + 256 + cgp * 8 + 4), bv0 = *(const f32x4*)(P.conv_ln_b + 256 + cgp * 8), bv1 = *(const f32x4*)(P.conv_ln_b + 256 + cgp * 8 + 4);
#pragma unroll
    for (int i = 0; i < 4; ++i) {
        float s1 = 0.f, s2 = 0.f;
#pragma unroll
        for (int e = 0; e < 8; ++e) { s1 += yh[i][e] + yv[i][e]; s2 += yh[i][e] * yh[i][e] + yv[i][e] * yv[i][e]; }
#pragma unroll
        for (int o = 1; o < 32; o <<= 1) { s1 += __shfl_xor(s1, o); s2 += __shfl_xor(s2, o); }
        const float mean = s1 * (1.0f / 512.f), var = fmaxf(s2 * (1.0f / 512.f) - mean * mean, 0.f), rstd = rsqrtf(var + EPS);
        float oh[8], ov[8];
#pragma unroll
        for (int e = 0; e < 4; ++e) {
            oh[e] = siluf_((yh[i][e] - mean) * rstd * gh0[e] + bh0[e]); oh[4 + e] = siluf_((yh[i][4 + e] - mean) * rstd * gh1[e] + bh1[e]);
            ov[e] = siluf_((yv[i][e] - mean) * rstd * gv0[e] + bv0[e]); ov[4 + e] = siluf_((yv[i][4 + e] - mean) * rstd * gv1[e] + bv1[e]); }
        bf16_t* dst = A1 + (tok0 + wq + 16 * i) * 512 + cgp * 8;
        u32x4 w; w.x = cvt_pk_bf16(oh[0], oh[1]); w.y = cvt_pk_bf16(oh[2], oh[3]); w.z = cvt_pk_bf16(oh[4], oh[5]); w.w = cvt_pk_bf16(oh[6], oh[7]);
        *(u32x4*)dst = w;
        w.x = cvt_pk_bf16(ov[0], ov[1]); w.y = cvt_pk_bf16(ov[2], ov[3]); w.z = cvt_pk_bf16(ov[4], ov[5]); w.w = cvt_pk_bf16(ov[6], ov[7]);
        *(u32x4*)(dst + 256) = w;
    }
    __syncthreads();
}

constexpr int GL_G = 0;
constexpr int GL_Z = 33792;
constexpr int GL_WD = GL_Z + 8192;
constexpr int GL_BD = GL_WD + 8192;
constexpr int GL_TOT = GL_BD + 512;
constexpr int GL_QC = GL_TOT + 2048;
constexpr int GL_KF = GL_QC + 64 * 136 * 2;
constexpr int GL_KB = GL_KF + 64 * 72 * 2;
constexpr int GL_VT = GL_KB + 64 * 72 * 2;
constexpr int GL_AS = GL_VT + 128 * 72 * 2;
constexpr int GL_SC = GL_AS + 64 * 72 * 2;
constexpr int GL_END = GL_SC + 128 * 136 * 2;
static_assert(GL_END <= LDS_BYTES, "gla lds");

__device__ __forceinline__ float log_sigmoid_(float x) { return fminf(x, 0.f) - __logf(1.0f + __expf(-fabsf(x))); }

__device__ __forceinline__ void vt_write(LAS bf16_t* VT, int t, int v8, const u32x4 vv) {
    VT[(v8 + 0) * 72 + t] = (bf16_t)(vv.x & 0xffff); VT[(v8 + 1) * 72 + t] = (bf16_t)(vv.x >> 16); VT[(v8 + 2) * 72 + t] = (bf16_t)(vv.y & 0xffff); VT[(v8 + 3) * 72 + t] = (bf16_t)(vv.y >> 16);
    VT[(v8 + 4) * 72 + t] = (bf16_t)(vv.z & 0xffff); VT[(v8 + 5) * 72 + t] = (bf16_t)(vv.z >> 16); VT[(v8 + 6) * 72 + t] = (bf16_t)(vv.w & 0xffff); VT[(v8 + 7) * 72 + t] = (bf16_t)(vv.w >> 16);
}
struct LocalRegs { f32x4 z, wd; float bd; u32x4 k, v[2]; };
__device__ __forceinline__ void gla_local_load(const Params& P, int b, int h, int idx, LocalRegs& R) {
    const int tid = threadIdx.x; unsigned char* ws = P.ws;
    const bool isctx = idx < 4;
    const size_t tok0 = isctx ? (size_t)b * CTXL + (size_t)idx * 64 : (size_t)b * SEQ + (size_t)(idx - 4) * 64;
    const float* zsrc = (const float*)(ws + (isctx ? WS_DECC : WS_DEC)) + tok0 * 32;
    const bf16_t* ksrc = (const bf16_t*)(ws + (isctx ? WS_KC : WS_K)) + tok0 * 256 + h * 64;
    const bf16_t* vsrc = (const bf16_t*)(ws + (isctx ? WS_VC : WS_V)) + tok0 * 512 + h * 128;
    R.z = ((const f32x4*)zsrc)[tid];
    { const int i4 = tid * 4, dir = i4 >> 10, r = (i4 >> 6) & 15, d = i4 & 63; R.wd = *(const f32x4*)(P.w_decay + (size_t)(dir * 16 + r) * 256 + h * 64 + d); }
    R.bd = (tid < 128) ? P.b_decay[(tid >> 6) * 256 + h * 64 + (tid & 63)] : 0.f;
    R.k = *(const u32x4*)(ksrc + (size_t)(tid & 63) * 256 + (tid >> 6) * 8);
#pragma unroll
    for (int i = 0; i < 2; ++i) { const int ix = tid + 512 * i; R.v[i] = *(const u32x4*)(vsrc + (size_t)(ix & 63) * 512 + (ix >> 6) * 8); }
}
__device__ __forceinline__ void gla_local_unit(const Params& P, LAS unsigned char* lds, int b, int h, int idx, const LocalRegs& R) {
    const int tid = threadIdx.x, lane = tid & 63, wave = tid >> 6, fr = lane & 15, fq = lane >> 4;
    unsigned char* ws = P.ws;
    const bool isctx = idx < 4;
    LAS float* Z = (LAS float*)(lds + GL_Z); LAS float* WD = (LAS float*)(lds + GL_WD); LAS float* BD = (LAS float*)(lds + GL_BD);
    LAS float* TOT = (LAS float*)(lds + GL_TOT); LAS float* G = (LAS float*)(lds + GL_G);
    LAS bf16_t* KF = (LAS bf16_t*)(lds + GL_KF); LAS bf16_t* KB = (LAS bf16_t*)(lds + GL_KB); LAS bf16_t* VT = (LAS bf16_t*)(lds + GL_VT);
    const f32x4 zreg = R.z, wdreg = R.wd; const float bdreg = R.bd; const u32x4 kreg = R.k; u32x4 vreg[2] = {R.v[0], R.v[1]};
    const int kt = tid & 63, kd8 = (tid >> 6) * 8;
    ((LAS f32x4*)Z)[tid] = zreg; ((LAS f32x4*)WD)[tid] = wdreg; if (tid < 128) BD[tid] = bdreg;
    __syncthreads();
    {
        const int dir = tid >> 8, q4 = (tid >> 6) & 3, d = tid & 63;
        f32x2 w2[8]; float la[16];
#pragma unroll
        for (int r = 0; r < 8; ++r) w2[r] = (f32x2){WD[(dir * 16 + 2 * r) * 64 + d], WD[(dir * 16 + 2 * r + 1) * 64 + d]};
        const float bias = BD[dir * 64 + d];
#pragma unroll
        for (int j = 0; j < 16; ++j) { const LAS f32x4* zp = (const LAS f32x4*)(Z + (q4 * 16 + j) * 32 + dir * 16); f32x2 a2 = (f32x2){bias, 0.f};
#pragma unroll
            for (int r4 = 0; r4 < 4; ++r4) { const f32x4 z = zp[r4]; a2 += (f32x2){z[0], z[1]} * w2[2 * r4]; a2 += (f32x2){z[2], z[3]} * w2[2 * r4 + 1]; }
            la[j] = log_sigmoid_(a2.x + a2.y) * (1.0f / 16.0f); }
        float tot;
        if (dir == 0) {
#pragma unroll
            for (int j = 1; j < 16; ++j) la[j] += la[j - 1];
            tot = la[15];
        } else {
#pragma unroll
            for (int j = 14; j >= 0; --j) la[j] += la[j + 1];
            tot = la[0];
        }
        TOT[(dir * 4 + q4) * 64 + d] = tot;
        __syncthreads();
        float off = 0.f;
#pragma unroll
        for (int q = 0; q < 4; ++q) { const float tq = TOT[(dir * 4 + q) * 64 + d]; if (dir == 0 ? (q < q4) : (q > q4)) off += tq; }
        _Float16* gb = (_Float16*)P.out + ((size_t)(b * 4 + h) * 32 + (idx - 4)) * 8192;
#pragma unroll
        for (int j = 0; j < 16; ++j) { const float g = la[j] + off; G[(dir * 64 + d) * 65 + q4 * 16 + j] = g; if (!isctx) gb[(dir * 64 + q4 * 16 + j) * 64 + d] = (_Float16)g; }
    }
    __syncthreads();
    { float kf[8]; unpack8(kreg, kf);
#pragma unroll
      for (int e = 0; e < 8; ++e) { const int d = kd8 + e; const float gf = G[d * 65 + kt], gfl = G[d * 65 + 63], gb_ = G[(64 + d) * 65 + kt], gb0 = G[(64 + d) * 65];
          KF[d * 72 + kt] = f2bf(kf[e] * __expf(gfl - gf)); KB[d * 72 + kt] = f2bf(kf[e] * __expf(gb0 - gb_)); } }
#pragma unroll
    for (int i = 0; i < 2; ++i) { const int ix = tid + 512 * i; vt_write(VT, ix & 63, (ix >> 6) * 8, vreg[i]); }
    const size_t chain0 = (size_t)(0 * 32 + b * 4 + h) * NCH + idx, chain1 = (size_t)(1 * 32 + b * 4 + h) * NCH + idx;
    if (tid < 128) { const int dir = tid >> 6, d = tid & 63; float* dv = (float*)(ws + WS_DVEC) + (dir ? chain1 : chain0) * 64;
        dv[d] = __expf(dir == 0 ? G[d * 65 + 63] : G[(64 + d) * 65]); }
    __syncthreads();
    { const int dir = wave >> 2, db = wave & 3; const LAS bf16_t* KD = dir ? KB : KF;
      bf16x8 aq[2];
#pragma unroll
      for (int kk = 0; kk < 2; ++kk) aq[kk] = *(const LAS bf16x8*)(KD + (16 * db + fr) * 72 + 32 * kk + 8 * fq);
      bf16_t* sb = (bf16_t*)(ws + WS_G) + (dir ? chain1 : chain0) * 8192;
#pragma unroll
      for (int vb = 0; vb < 8; ++vb) { f32x4 acc = (f32x4){0.f, 0.f, 0.f, 0.f};
#pragma unroll
          for (int kk = 0; kk < 2; ++kk) { const bf16x8 bq = *(const LAS bf16x8*)(VT + (16 * vb + fr) * 72 + 32 * kk + 8 * fq); acc = __builtin_amdgcn_mfma_f32_16x16x32_bf16(aq[kk], bq, acc, 0, 0, 0); }
          u32x2 w2; w2.x = cvt_pk_bf16(acc[0], acc[1]); w2.y = cvt_pk_bf16(acc[2], acc[3]);
          *(u32x2*)(sb + (16 * vb + fr) * 64 + 16 * db + 4 * fq) = w2; } }
}
__device__ __forceinline__ void gla_scan_phase(const Params& P) {
    const int gt = blockIdx.x * NTHREADS + threadIdx.x, NT = gridDim.x * NTHREADS;
    for (int id = gt; id < 64 * 4096; id += NT) {
        const int chain = id >> 12, e2 = id & 4095, dir = chain >> 5, d = (2 * e2) & 63;
        unsigned* base = (unsigned*)(P.ws + WS_G) + (size_t)chain * NCH * 4096 + e2;
        const float* dv = (const float*)(P.ws + WS_DVEC) + (size_t)chain * NCH * 64 + d;
        unsigned L[NCH]; f32x2 dd[NCH];
#pragma unroll
        for (int step = 0; step < NCH; ++step) { const int idx = (dir == 0) ? step : (step < 4 ? 3 - step : 39 - step);
            L[step] = __builtin_nontemporal_load(base + (size_t)idx * 4096); dd[step] = *(const f32x2*)(dv + idx * 64); }
        float s0 = 0.f, s1 = 0.f;
#pragma unroll
        for (int step = 0; step < NCH; ++step) { const int idx = (dir == 0) ? step : (step < 4 ? 3 - step : 39 - step);
            if (step >= 4) base[(size_t)idx * 4096] = cvt_pk_bf16(s0, s1);
            s0 = dd[step].x * s0 + bflo(L[step]); s1 = dd[step].y * s1 + bfhi(L[step]); }
    }
}
struct OutRegs { u32x4 gfh, gbh; u32x4 q, k, v[2], sf[2], sb[2]; unsigned r[8]; };
__device__ __forceinline__ void gla_out_load(const Params& P, int b, int h, int c, OutRegs& R) {
    const int tid = threadIdx.x, lane = tid & 63, wave = tid >> 6; unsigned char* ws = P.ws;
    const size_t tok0 = (size_t)b * SEQ + (size_t)c * 64;
    const bf16_t* qsrc = (const bf16_t*)(ws + WS_Q) + tok0 * 256 + h * 64;
    const bf16_t* ksrc = (const bf16_t*)(ws + WS_K) + tok0 * 256 + h * 64;
    const bf16_t* vsrc = (const bf16_t*)(ws + WS_V) + tok0 * 512 + h * 128;
    const _Float16* gsrc = (const _Float16*)P.out + ((size_t)(b * 4 + h) * 32 + c) * 8192;
    const bf16_t* sf = (const bf16_t*)(ws + WS_G) + ((size_t)(b * 4 + h) * NCH + 4 + c) * 8192;
    const bf16_t* sbk = (const bf16_t*)(ws + WS_G) + ((size_t)(32 + b * 4 + h) * NCH + 4 + c) * 8192;
    const bf16_t* RB = (const bf16_t*)(ws + WS_R);
    const int t = tid >> 3, d8 = (tid & 7) * 8;
    R.gfh = __builtin_nontemporal_load((const u32x4*)(gsrc + t * 64 + d8)); R.gbh = __builtin_nontemporal_load((const u32x4*)(gsrc + (64 + t) * 64 + d8));
    R.q = __builtin_nontemporal_load((const u32x4*)(qsrc + (size_t)t * 256 + d8)); R.k = __builtin_nontemporal_load((const u32x4*)(ksrc + (size_t)t * 256 + d8));
#pragma unroll
    for (int i = 0; i < 2; ++i) { const int ix = tid + 512 * i; R.v[i] = __builtin_nontemporal_load((const u32x4*)(vsrc + (size_t)(ix & 63) * 512 + (ix >> 6) * 8));
        R.sf[i] = __builtin_nontemporal_load((const u32x4*)(sf + (ix >> 3) * 64 + (ix & 7) * 8)); R.sb[i] = __builtin_nontemporal_load((const u32x4*)(sbk + (ix >> 3) * 64 + (ix & 7) * 8)); }
#pragma unroll
    for (int i = 0; i < 8; ++i) R.r[i] = __builtin_nontemporal_load((const unsigned*)(RB + (tok0 + wave * 8 + i) * 512 + h * 128 + 2 * lane));
}
__device__ __forceinline__ void gla_out_unit(const Params& P, LAS unsigned char* lds, int b, int h, int c, const OutRegs& R) {
    const int tid = threadIdx.x, lane = tid & 63, wave = tid >> 6, fr = lane & 15, fq = lane >> 4;
    unsigned char* ws = P.ws;
    const size_t tok0 = (size_t)b * SEQ + (size_t)c * 64;
    LAS bf16_t* QC = (LAS bf16_t*)(lds + GL_QC); LAS bf16_t* KF = (LAS bf16_t*)(lds + GL_KF); LAS bf16_t* KB = (LAS bf16_t*)(lds + GL_KB);
    LAS bf16_t* VT = (LAS bf16_t*)(lds + GL_VT); LAS bf16_t* AS = (LAS bf16_t*)(lds + GL_AS); LAS bf16_t* SC = (LAS bf16_t*)(lds + GL_SC);
    const int t = tid >> 3, d8 = (tid & 7) * 8;
    const u32x4 qreg = R.q, kreg = R.k;
    float gfa[8], gba[8];
    { const unsigned f0 = R.gfh.x, f1 = R.gfh.y, f2 = R.gfh.z, f3 = R.gfh.w, b0 = R.gbh.x, b1 = R.gbh.y, b2 = R.gbh.z, b3 = R.gbh.w;
      const h2_t hf0 = as_h2(f0), hf1 = as_h2(f1), hf2 = as_h2(f2), hf3 = as_h2(f3), hb0 = as_h2(b0), hb1 = as_h2(b1), hb2 = as_h2(b2), hb3 = as_h2(b3);
      gfa[0] = (float)hf0.x; gfa[1] = (float)hf0.y; gfa[2] = (float)hf1.x; gfa[3] = (float)hf1.y; gfa[4] = (float)hf2.x; gfa[5] = (float)hf2.y; gfa[6] = (float)hf3.x; gfa[7] = (float)hf3.y;
      gba[0] = (float)hb0.x; gba[1] = (float)hb0.y; gba[2] = (float)hb1.x; gba[3] = (float)hb1.y; gba[4] = (float)hb2.x; gba[5] = (float)hb2.y; gba[6] = (float)hb3.x; gba[7] = (float)hb3.y; }
    u32x4 vreg[2] = {R.v[0], R.v[1]}, sfr[2] = {R.sf[0], R.sf[1]}, sbr[2] = {R.sb[0], R.sb[1]};
    unsigned rreg[8];
#pragma unroll
    for (int i = 0; i < 8; ++i) rreg[i] = R.r[i];
    { float qf[8], kf[8]; unpack8(qreg, qf); unpack8(kreg, kf);
      float a[8], bb[8], cc[8], dd[8];
#pragma unroll
      for (int e = 0; e < 8; ++e) { const float gf = gfa[e], gb = gba[e];
          a[e] = qf[e] * __expf(gf); bb[e] = qf[e] * __expf(gb); cc[e] = kf[e] * __expf(-gf); dd[e] = kf[e] * __expf(-gb); }
      u32x4 w;
      w.x = cvt_pk_bf16(a[0], a[1]); w.y = cvt_pk_bf16(a[2], a[3]); w.z = cvt_pk_bf16(a[4], a[5]); w.w = cvt_pk_bf16(a[6], a[7]); *(LAS u32x4*)(QC + t * 136 + d8) = w;
      w.x = cvt_pk_bf16(bb[0], bb[1]); w.y = cvt_pk_bf16(bb[2], bb[3]); w.z = cvt_pk_bf16(bb[4], bb[5]); w.w = cvt_pk_bf16(bb[6], bb[7]); *(LAS u32x4*)(QC + t * 136 + 64 + d8) = w;
      w.x = cvt_pk_bf16(cc[0], cc[1]); w.y = cvt_pk_bf16(cc[2], cc[3]); w.z = cvt_pk_bf16(cc[4], cc[5]); w.w = cvt_pk_bf16(cc[6], cc[7]); *(LAS u32x4*)(KF + t * 72 + d8) = w;
      w.x = cvt_pk_bf16(dd[0], dd[1]); w.y = cvt_pk_bf16(dd[2], dd[3]); w.z = cvt_pk_bf16(dd[4], dd[5]); w.w = cvt_pk_bf16(dd[6], dd[7]); *(LAS u32x4*)(KB + t * 72 + d8) = w; }
#pragma unroll
    for (int i = 0; i < 2; ++i) { const int ix = tid + 512 * i; vt_write(VT, ix & 63, (ix >> 6) * 8, vreg[i]);
        *(LAS u32x4*)(SC + (ix >> 3) * 136 + (ix & 7) * 8) = sfr[i]; *(LAS u32x4*)(SC + (ix >> 3) * 136 + 64 + (ix & 7) * 8) = sbr[i]; }
    __syncthreads();
    { const int tb = wave >> 1;
#pragma unroll
      for (int s2 = 0; s2 < 2; ++s2) { const int sb = 2 * (wave & 1) + s2;
          f32x4 af = (f32x4){0.f, 0.f, 0.f, 0.f}, ab = (f32x4){0.f, 0.f, 0.f, 0.f};
          if (tb >= sb) {
#pragma unroll
              for (int kk = 0; kk < 2; ++kk) { const bf16x8 aq = *(const LAS bf16x8*)(QC + (16 * tb + fr) * 136 + 32 * kk + 8 * fq), bq = *(const LAS bf16x8*)(KF + (16 * sb + fr) * 72 + 32 * kk + 8 * fq);
                  af = __builtin_amdgcn_mfma_f32_16x16x32_bf16(aq, bq, af, 0, 0, 0); } }
          if (tb <= sb) {
#pragma unroll
              for (int kk = 0; kk < 2; ++kk) { const bf16x8 aq = *(const LAS bf16x8*)(QC + (16 * tb + fr) * 136 + 64 + 32 * kk + 8 * fq), bq = *(const LAS bf16x8*)(KB + (16 * sb + fr) * 72 + 32 * kk + 8 * fq);
                  ab = __builtin_amdgcn_mfma_f32_16x16x32_bf16(aq, bq, ab, 0, 0, 0); } }
#pragma unroll
          for (int r = 0; r < 4; ++r) { const int tt = 16 * tb + 4 * fq + r, s = 16 * sb + fr; const float val = (s <= tt ? af[r] : 0.f) + (s >= tt ? ab[r] : 0.f); AS[tt * 72 + s] = f2bf(val); } } }
    __syncthreads();
    { const int tb = wave >> 1; LAS float* OB = (LAS float*)(lds + GL_G);
      bf16x8 aas[2], aqc[4];
#pragma unroll
      for (int kk = 0; kk < 2; ++kk) aas[kk] = *(const LAS bf16x8*)(AS + (16 * tb + fr) * 72 + 32 * kk + 8 * fq);
#pragma unroll
      for (int kk = 0; kk < 4; ++kk) aqc[kk] = *(const LAS bf16x8*)(QC + (16 * tb + fr) * 136 + 32 * kk + 8 * fq);
#pragma unroll
      for (int v4 = 0; v4 < 4; ++v4) { const int vb = 4 * (wave & 1) + v4; f32x4 acc = (f32x4){0.f, 0.f, 0.f, 0.f};
#pragma unroll
          for (int kk = 0; kk < 2; ++kk) { const bf16x8 bq = *(const LAS bf16x8*)(VT + (16 * vb + fr) * 72 + 32 * kk + 8 * fq); acc = __builtin_amdgcn_mfma_f32_16x16x32_bf16(aas[kk], bq, acc, 0, 0, 0); }
#pragma unroll
          for (int kk = 0; kk < 4; ++kk) { const bf16x8 bq = *(const LAS bf16x8*)(SC + (16 * vb + fr) * 136 + 32 * kk + 8 * fq); acc = __builtin_amdgcn_mfma_f32_16x16x32_bf16(aqc[kk], bq, acc, 0, 0, 0); }
#pragma unroll
          for (int r = 0; r < 4; ++r) OB[(16 * tb + 4 * fq + r) * 132 + 16 * vb + fr] = acc[r]; } }
    __syncthreads();
    { const LAS float* OB = (const LAS float*)(lds + GL_G); bf16_t* A2 = (bf16_t*)(ws + WS_U) + (size_t)MTOK * 512;
      const f32x2 g = *(const f32x2*)(P.gla_norm_g + 2 * lane);
#pragma unroll
      for (int i = 0; i < 8; ++i) { const int tt = wave * 8 + i; const f32x2 o = *(const LAS f32x2*)(OB + tt * 132 + 2 * lane);
          const float rs = rsqrtf(wave_sum(o.x * o.x + o.y * o.y) * (1.0f / 128.f) + EPS);
          *(unsigned*)(A2 + (tok0 + tt) * 512 + h * 128 + 2 * lane) = cvt_pk_bf16(o.x * rs * g.x * bflo(rreg[i]), o.y * rs * g.y * bfhi(rreg[i])); } }
}

#define XB_TMO      128
#define XB_XCNT(j)  (256  + 64 * (j))
#define XB_XSUB(j)  (1280 + 64 * (j))
#define XB_XGEN(j)  (2304 + 64 * (j))
#define XB_TOP      3328
#define XB_TOPGEN   3392
__device__ __forceinline__ unsigned xb_add(unsigned* p, unsigned v) { return __hip_atomic_fetch_add(p, v, __ATOMIC_RELAXED, __HIP_MEMORY_SCOPE_AGENT); }
__device__ __forceinline__ unsigned xb_xcc_id() { return (unsigned)__builtin_amdgcn_s_getreg((3 << 11) | 20) & 0xFu; }
#define XB_SPIN(cond, bar) do { unsigned _sp = 0; while (cond) { __builtin_amdgcn_s_sleep(1); \
    if ((++_sp & 255u) == 0u) { if (xb_ld(&(bar)[XB_TMO])) break; if (_sp > XB_SPIN_CAP) { atomicAdd(&(bar)[XB_TMO], 1u); break; } } } } while (0)
struct XcdBarrier { unsigned* bar; unsigned x; volatile LAS unsigned* st; };
__device__ __forceinline__ XcdBarrier xcd_barrier_post(unsigned* bar, volatile LAS unsigned* st) {
    XcdBarrier b; b.bar = bar; b.x = xb_xcc_id(); b.st = st;
    if (threadIdx.x == 0) (void)xb_add(&bar[XB_XCNT(b.x)], 1u);
    return b;
}
__device__ __forceinline__ void xcd_barrier_complete(unsigned* bar, unsigned x, unsigned& nloc, unsigned& nx) {
    const unsigned G = gridDim.x * gridDim.y * gridDim.z;
    unsigned sum, cnt, mine, sp = 0u;
    for (;;) {
        sum = 0u; cnt = 0u; mine = 0u;
#pragma unroll
        for (unsigned j = 0; j < 16; ++j) { const unsigned c = xb_ld(&bar[XB_XCNT(j)]); sum += c; cnt += (c > 0u) ? 1u : 0u; mine = (j == x) ? c : mine; }
        if (sum == G) break;
        __builtin_amdgcn_s_sleep(1);
        if ((++sp & 255u) == 0u) { if (xb_ld(&bar[XB_TMO])) break; if (sp > XB_SPIN_CAP) { atomicAdd(&bar[XB_TMO], 1u); break; } }
    }
    nloc = mine > 0u ? mine : 1u; nx = cnt > 0u ? cnt : 1u;
}
__device__ __forceinline__ void xcd_barrier(const XcdBarrier& b) {
    asm volatile("s_waitcnt vmcnt(0)" ::: "memory");
    __syncthreads();
    if (threadIdx.x == 0) {
        unsigned* bar = b.bar;
        __builtin_amdgcn_s_waitcnt(0);
        unsigned nloc = b.st[0], nx = b.st[1];
        if (nloc == 0u) { xcd_barrier_complete(bar, b.x, nloc, nx); b.st[0] = nloc; b.st[1] = nx; }
        const unsigned old = xb_add(&bar[XB_XSUB(b.x)], 1u);
        const unsigned gen = old / nloc;
        if (old + 1u == (gen + 1u) * nloc) {
            __builtin_amdgcn_fence(__ATOMIC_RELEASE, "agent");
            asm volatile("s_waitcnt vmcnt(0)" ::: "memory");
            const unsigned og = xb_add(&bar[XB_TOP], 1u);
            const unsigned tg = og / nx;
            if (og + 1u == (tg + 1u) * nx) xb_add(&bar[XB_TOPGEN], 1u);
            else XB_SPIN(xb_ld(&bar[XB_TOPGEN]) == tg, bar);
            __builtin_amdgcn_fence(__ATOMIC_ACQUIRE, "agent");
            xb_add(&bar[XB_XGEN(b.x)], 1u);
            asm volatile("s_waitcnt vmcnt(0)" ::: "memory");
        } else {
            XB_SPIN(xb_ld(&bar[XB_XGEN(b.x)]) == gen, bar);
            __builtin_amdgcn_fence(__ATOMIC_ACQUIRE, "agent");
            asm volatile("s_waitcnt vmcnt(0)" ::: "memory");
        }
    }
    __syncthreads();
}

__global__ void __launch_bounds__(NTHREADS, 2) fwd_megakernel(Params P) {
    extern __shared__ __attribute__((aligned(16))) unsigned char lds_raw[];
    LAS unsigned char* lds = (LAS unsigned char*)lds_raw;
    cg::grid_group grid = cg::this_grid();
    const int lo = P.ph_lo, hi = P.ph_hi;
    const int G = gridDim.x, c = blockIdx.x;
    unsigned char* ws = P.ws;
#define IN(k) (lo <= (k) && (k) < hi)
    volatile LAS unsigned* xst = (volatile LAS unsigned*)(lds + LDS_BYTES - 16);
    if (threadIdx.x < 4) xst[threadIdx.x] = 0u;
    __syncthreads();
    XcdBarrier xb = xcd_barrier_post((unsigned*)(ws + WS_BAR), xst);
    if (P.ph_hi == 12345) grid.sync();
#define SEAM(k) do { if (IN((k) + 1)) xcd_barrier(xb); } while (0)
    if (IN(0)) { phase0(P, lds); SEAM(0); }
    if (IN(1)) { phase1(P); SEAM(1); }
    if (IN(2)) { SchedProj S{(const char*)(ws + WS_U), (const char*)(ws + WS_UC), (const char*)(ws + WS_WIN), G, c}; EpiProj E{ws};
        gemm_phase<D, SchedProj, EpiProj>(lds, S, E); SEAM(2); }
    if (IN(3)) {
        { LocalRegs R0, R1; int u = c; bool have = u < NB * NH * NCH;
          if (have) gla_local_load(P, (u / NCH) >> 2, (u / NCH) & 3, u % NCH, R0);
          for (int uc = c; uc < NB * 32; uc += G) conv_unit(P, lds, uc & 7, uc >> 3);
          while (have) { const int un = u + G; const bool hn = un < NB * NH * NCH;
              if (hn) gla_local_load(P, (un / NCH) >> 2, (un / NCH) & 3, un % NCH, R1);
              gla_local_unit(P, lds, (u / NCH) >> 2, (u / NCH) & 3, u % NCH, R0);
              R0 = R1; u = un; have = hn; } }
        SEAM(3); }
    if (IN(4)) { gla_scan_phase(P); SEAM(4); }
    if (IN(5)) {
        { OutRegs R0, R1; int u = c; bool have = u < NB * NH * 32;
          if (have) gla_out_load(P, (u >> 5) >> 2, (u >> 5) & 3, u & 31, R0);
          while (have) { const int un = u + G; const bool hn = un < NB * NH * 32;
              if (hn) gla_out_load(P, (un >> 5) >> 2, (un >> 5) & 3, un & 31, R1);
              gla_out_unit(P, lds, (u >> 5) >> 2, (u >> 5) & 3, u & 31, R0);
              R0 = R1; u = un; have = hn; } }
        SEAM(5); }
    if (IN(6)) { SchedMerge S{(const char*)(ws + WS_U), (const char*)(ws + WS_U) + (size_t)MTOK * 512 * 2, (const char*)(ws + WS_WCONV), (const char*)(ws + WS_WGLA), G, c}; EpiMerge E{ws};
        gemm_phase<512, SchedMerge, EpiMerge>(lds, S, E); SEAM(6); }
    if (IN(7)) { SchedPlain<D> S{(const char*)(ws + WS_MERGED), (const char*)(ws + WS_WOUT), 64, 4, G, c};
        if (G == 256) {
            EpiMid E{P.x, (bf16_t*)(ws + WS_Y), (bf16_t*)(ws + WS_U), (const float*)(ws + WS_MOD), P.g_post1, P.g_pre2, (float*)(ws + WS_XBUF) + (size_t)MTOK * 4, (unsigned*)(ws + WS_XCNT) + 4096, (unsigned*)(ws + WS_BAR) + XB_TMO};
            gemm_phase<D, SchedPlain<D>, EpiMid>(lds, S, E); SEAM(8);
        } else { EpiBf16Plain E{(bf16_t*)(ws + WS_Y)};
            gemm_phase<D, SchedPlain<D>, EpiBf16Plain>(lds, S, E); SEAM(7); } }
    if (IN(8) && G != 256) { phase8(P); SEAM(8); }
    if (IN(9)) { SchedPlain<D> S{(const char*)(ws + WS_U), (const char*)(ws + WS_WFF1), 64, 16, G, c}; EpiRelu2 E{(bf16_t*)(ws + WS_FFACT)};
        gemm_phase<D, SchedPlain<D>, EpiRelu2>(lds, S, E); SEAM(9); }
    if (IN(10)) { SchedPlain<DFF> S{(const char*)(ws + WS_FFACT), (const char*)(ws + WS_WFF2), 64, 4, G, c};
        if (G == 256) {
            EpiFinal E{P.out, (const bf16_t*)(ws + WS_Y), (const float*)(ws + WS_MOD), P.g_post2, (float*)(ws + WS_XBUF), (unsigned*)(ws + WS_XCNT), (unsigned*)(ws + WS_BAR) + XB_TMO};
            gemm_phase<DFF, SchedPlain<DFF>, EpiFinal>(lds, S, E);
        } else { EpiBf16Plain E{(bf16_t*)(ws + WS_FF2OUT)};
            gemm_phase<DFF, SchedPlain<DFF>, EpiBf16Plain>(lds, S, E); SEAM(10); } }
    if (IN(11) && G != 256) { phase11(P); }
#undef IN
#undef SEAM
}

extern "C" void kernel_launch(void* const* d_in, const int* in_sizes, int n_in, void* d_out, int out_size, void* d_ws, size_t ws_size, hipStream_t stream) {
    static int grid_blocks = 0;
    if (grid_blocks == 0) {
        int dev = 0, cus = 0, per_cu = 0;
        hipGetDevice(&dev);
        hipDeviceGetAttribute(&cus, hipDeviceAttributeMultiprocessorCount, dev);
        if (hipFuncSetAttribute((const void*)fwd_megakernel, hipFuncAttributeMaxDynamicSharedMemorySize, LDS_BYTES) != hipSuccess) { fprintf(stderr, "hipFuncSetAttribute failed\n"); }
        if (hipOccupancyMaxActiveBlocksPerMultiprocessor(&per_cu, (const void*)fwd_megakernel, NTHREADS, LDS_BYTES) != hipSuccess || per_cu < 1) { fprintf(stderr, "occupancy query: %d\n", per_cu); per_cu = 1; }
        (void)hipGetLastError();
        grid_blocks = cus * 1;
        if (grid_blocks <= 0) grid_blocks = 256;
        if (n_in != 23 || ws_size < WS_END) fprintf(stderr, "kernel_launch: unexpected n_in %d / ws %zu\n", n_in, ws_size);
    }
    Params p{};
    const float** pp = (const float**)&p;
    for (int i = 0; i < 23; ++i) pp[i] = (const float*)d_in[i];
    p.out = (float*)d_out; p.ws = (unsigned char*)d_ws;
#if MK_MULTI_LAUNCH
    for (int k = 0; k < 12; ++k) { p.ph_lo = k; p.ph_hi = k + 1; hipLaunchKernelGGL(fwd_megakernel, dim3(grid_blocks), dim3(NTHREADS), LDS_BYTES, stream, p); }
#else
    p.ph_lo = 0; p.ph_hi = 12;
    (void)hipMemsetAsync((unsigned char*)d_ws + WS_BAR, 0, CTL_ZERO_BYTES, stream);
    void* args[] = {&p};
    hipError_t e = hipLaunchCooperativeKernel((const void*)fwd_megakernel, dim3(grid_blocks), dim3(NTHREADS), args, LDS_BYTES, stream);
    if (e != hipSuccess) fprintf(stderr, "cooperative launch failed: %s (grid %d)\n", hipGetErrorString(e), grid_blocks);
#endif
}
```
